# Optimizing an MI355X kernel written in HIP

```python
import math
import jax, jax.numpy as jnp
from jax import lax
import numpy as np

D_MODEL = 1024
BATCH = 8
SEQ = 2048
DEPTH = 1
DEC_BATCH = 128
DEC_SEQ = 4
PAST_LEN = 16384
PAGE_SIZE = 128

S5_GROUP = 16
S5_WIDTH = D_MODEL // 2
S5_GROUPS = S5_WIDTH // S5_GROUP
S5_STATE = 64
S5_DT_MIN = 0.001
S5_DT_MAX = 0.1
HG_HEADS = 8
HG_DK = D_MODEL // HG_HEADS
HG_DV = D_MODEL // HG_HEADS
HG_KEY_WIDTH = HG_HEADS * HG_DK
HG_VAL_WIDTH = HG_HEADS * HG_DV
HG_CHUNK = 32
D_FF = 4 * D_MODEL
IN_COLS = S5_WIDTH + 2 * HG_KEY_WIDTH + 2 * HG_VAL_WIDTH + 2 * D_MODEL
SPLIT_POINTS = [S5_WIDTH,
                S5_WIDTH + HG_KEY_WIDTH,
                S5_WIDTH + 2 * HG_KEY_WIDTH,
                S5_WIDTH + 2 * HG_KEY_WIDTH + HG_VAL_WIDTH,
                S5_WIDTH + 2 * HG_KEY_WIDTH + 2 * HG_VAL_WIDTH,
                S5_WIDTH + 2 * HG_KEY_WIDTH + 2 * HG_VAL_WIDTH + D_MODEL]
NORM_EPS = 1e-6

kernel_name = "s5_hgrn2_gated_parallel_decoder_step"

f32 = jnp.float32


def rms_norm(x, g):
    xf = x.astype(f32)
    y = xf * lax.rsqrt(jnp.mean(xf * xf, axis=-1, keepdims=True) + NORM_EPS)
    return (y * g.astype(f32)).astype(x.dtype)


def s5_discretise(a_re, a_im, log_dt, b_re, b_im):
    dt = jnp.exp(log_dt)[:, None]
    mag = jnp.exp(dt * a_re)
    ab_re = mag * jnp.cos(dt * a_im)
    ab_im = mag * jnp.sin(dt * a_im)
    den = a_re * a_re + a_im * a_im
    nr = ab_re - 1.0
    ni = ab_im
    coef_re = (nr * a_re + ni * a_im) / den
    coef_im = (ni * a_re - nr * a_im) / den
    bb_re = coef_re[..., None] * b_re - coef_im[..., None] * b_im
    bb_im = coef_re[..., None] * b_im + coef_im[..., None] * b_re
    return ab_re, ab_im, bb_re, bb_im


def s5_combine(e1, e2):
    a1r, a1i, b1r, b1i = e1
    a2r, a2i, b2r, b2i = e2
    ar = a1r * a2r - a1i * a2i
    ai = a1r * a2i + a1i * a2r
    br = a2r * b1r - a2i * b1i + b2r
    bi = a2r * b1i + a2i * b1r + b2i
    return (ar, ai, br, bi)


def s5_mixer(u, h0_re, h0_im, a_re, a_im, log_dt, b_re, b_im, c_re, c_im, d, w_glu, b_glu):
    bsz, L, _ = u.shape
    uf = u.astype(f32)
    ug = uf.reshape(bsz, L, S5_GROUPS, S5_GROUP)
    ab_re, ab_im, bb_re, bb_im = s5_discretise(a_re.astype(f32), a_im.astype(f32), log_dt.astype(f32),
                                               b_re.astype(f32), b_im.astype(f32))
    bu_re = jnp.einsum('gnc,blgc->blgn', bb_re, ug)
    bu_im = jnp.einsum('gnc,blgc->blgn', bb_im, ug)
    shp = (bsz, L, S5_GROUPS, S5_STATE)
    elems = (jnp.broadcast_to(ab_re, shp), jnp.broadcast_to(ab_im, shp), bu_re, bu_im)
    pr, pi, sr, si = lax.associative_scan(s5_combine, elems, axis=1)
    h0r = h0_re.astype(f32)[:, None]
    h0i = h0_im.astype(f32)[:, None]
    h_re = pr * h0r - pi * h0i + sr
    h_im = pr * h0i + pi * h0r + si
    y = (jnp.einsum('gcn,blgn->blgc', c_re.astype(f32), h_re)
         - jnp.einsum('gcn,blgn->blgc', c_im.astype(f32), h_im))
    y = y.reshape(bsz, L, S5_WIDTH) + d.astype(f32) * uf
    y = jax.nn.gelu(y)
    y = y * jax.nn.sigmoid(y @ w_glu.astype(f32) + b_glu.astype(f32))
    return y.astype(u.dtype), h_re[:, -1], h_im[:, -1]


def hgrn2_mixer(q_raw, f_raw, i_raw, g_raw, s0, lb, norm_g):
    bsz, L, _ = q_raw.shape
    C = math.gcd(L, HG_CHUNK)
    nc = L // C
    q = jax.nn.silu(q_raw.astype(f32))
    f = lb.astype(f32) + (1.0 - lb.astype(f32)) * jax.nn.sigmoid(f_raw.astype(f32))
    log_f = jnp.log(f)
    k = 1.0 - f
    v = i_raw.astype(f32)

    def to_chunks(t, width):
        return jnp.moveaxis(t.reshape(bsz, nc, C, HG_HEADS, width), 1, 0)

    xs = (to_chunks(q, HG_DK), to_chunks(k, HG_DK), to_chunks(v, HG_DV), to_chunks(log_f, HG_DK))
    causal = jnp.tril(jnp.ones((C, C), dtype=bool))

    def chunk_step(S, chunk):
        qc, kc, vc, lfc = chunk
        b = jnp.cumsum(lfc, axis=1)
        o_inter = jnp.einsum('bthk,bhkv->bthv', qc * jnp.exp(b), S)
        diff = b[:, :, None] - b[:, None, :]
        decay = jnp.exp(jnp.where(causal[None, :, :, None, None], diff, -jnp.inf))
        scores = jnp.einsum('bthk,bshk,btshk->btsh', qc, kc, decay)
        o_intra = jnp.einsum('btsh,bshv->bthv', scores, vc)
        b_last = b[:, -1]
        S_new = (jnp.exp(b_last)[..., None] * S
                 + jnp.einsum('bshk,bshv->bhkv', kc * jnp.exp(b_last[:, None] - b), vc))
        return S_new, o_inter + o_intra

    S_fin, o = lax.scan(chunk_step, s0.astype(f32), xs)
    o = jnp.moveaxis(o, 0, 1).reshape(bsz, L, HG_HEADS, HG_DV)
    o = o * lax.rsqrt(jnp.mean(o * o, axis=-1, keepdims=True) + NORM_EPS) * norm_g.astype(f32)
    o = o * jax.nn.silu(g_raw.astype(f32).reshape(bsz, L, HG_HEADS, HG_DV))
    return o.reshape(bsz, L, HG_VAL_WIDTH).astype(q_raw.dtype), S_fin


def trunk_layer(x, s5_h0_re, s5_h0_im, hg_s0, lb,
                norm_mix_pre, norm_mix_post, norm_mlp_pre, norm_mlp_post, w_in, b_in,
                s5_a_re, s5_a_im, s5_log_dt, s5_b_re, s5_b_im, s5_c_re, s5_c_im, s5_d, s5_w_glu, s5_b_glu,
                hg_norm, w_br_s5, w_br_hg, w_out, w_up, w_down):
    h = rms_norm(x, norm_mix_pre)
    proj = h @ w_in + b_in
    u, q, f, i, g, gate_s5, gate_hg = jnp.split(proj, SPLIT_POINTS, axis=-1)
    y_s5, s5_re, s5_im = s5_mixer(u, s5_h0_re, s5_h0_im, s5_a_re, s5_a_im, s5_log_dt,
                                  s5_b_re, s5_b_im, s5_c_re, s5_c_im, s5_d, s5_w_glu, s5_b_glu)
    y_hg, hg_s = hgrn2_mixer(q, f, i, g, hg_s0, lb, hg_norm)
    merged = jax.nn.sigmoid(gate_s5) * (y_s5 @ w_br_s5) + jax.nn.sigmoid(gate_hg) * (y_hg @ w_br_hg)
    x = x + rms_norm(merged @ w_out, norm_mix_post)
    h2 = rms_norm(x, norm_mlp_pre)
    m = jnp.square(jax.nn.relu(h2 @ w_up)) @ w_down
    x = x + rms_norm(m, norm_mlp_post)
    return x, s5_re, s5_im, hg_s


def setup_inputs(seed: int = 0) -> dict:
    key = jax.random.key(seed)
    ks = jax.random.split(key, 32)
    nrm = lambda k, shp, s: jax.random.normal(k, shp, f32) * s
    n_idx = jnp.arange(S5_STATE, dtype=f32)
    a_re = -0.5 + nrm(ks[10], (DEPTH, S5_GROUPS, S5_STATE), 0.01)
    a_im = math.pi * n_idx[None, None, :] + nrm(ks[11], (DEPTH, S5_GROUPS, S5_STATE), 0.01)
    log_dt = jax.random.uniform(ks[12], (DEPTH, S5_GROUPS), f32,
                                math.log(S5_DT_MIN), math.log(S5_DT_MAX))
    return {
        "x_prompt": nrm(ks[0], (BATCH, SEQ, D_MODEL), 1.0),
        "x_sample": nrm(ks[1], (DEC_BATCH, DEC_SEQ, D_MODEL), 1.0),
        "state_s5_re": nrm(ks[2], (DEPTH, DEC_BATCH, S5_GROUPS, S5_STATE), 0.3),
        "state_s5_im": nrm(ks[3], (DEPTH, DEC_BATCH, S5_GROUPS, S5_STATE), 0.3),
        "state_hg": nrm(ks[4], (DEPTH, DEC_BATCH, HG_HEADS, HG_DK, HG_DV), 0.3),
        "norm_mix_pre": 1.0 + nrm(ks[5], (DEPTH, D_MODEL), 0.02),
        "norm_mix_post": 1.0 + nrm(ks[6], (DEPTH, D_MODEL), 0.02),
        "norm_mlp_pre": 1.0 + nrm(ks[7], (DEPTH, D_MODEL), 0.02),
        "norm_mlp_post": 1.0 + nrm(ks[8], (DEPTH, D_MODEL), 0.02),
        "w_in": nrm(ks[9], (DEPTH, D_MODEL, IN_COLS), D_MODEL ** -0.5),
        "b_in": nrm(ks[13], (DEPTH, IN_COLS), 0.01),
        "s5_a_re": a_re,
        "s5_a_im": a_im,
        "s5_log_dt": log_dt,
        "s5_b_re": nrm(ks[14], (DEPTH, S5_GROUPS, S5_STATE, S5_GROUP), S5_GROUP ** -0.5),
        "s5_b_im": nrm(ks[15], (DEPTH, S5_GROUPS, S5_STATE, S5_GROUP), S5_GROUP ** -0.5),
        "s5_c_re": nrm(ks[16], (DEPTH, S5_GROUPS, S5_GROUP, S5_STATE), S5_STATE ** -0.5),
        "s5_c_im": nrm(ks[17], (DEPTH, S5_GROUPS, S5_GROUP, S5_STATE), S5_STATE ** -0.5),
        "s5_d": nrm(ks[18], (DEPTH, S5_WIDTH), 0.5),
        "s5_w_glu": nrm(ks[19], (DEPTH, S5_WIDTH, S5_WIDTH), S5_WIDTH ** -0.5),
        "s5_b_glu": nrm(ks[20], (DEPTH, S5_WIDTH), 0.01),
        "hg_lb_logits": nrm(ks[21], (DEPTH + 1, HG_KEY_WIDTH), 0.1),
        "hg_norm": 1.0 + nrm(ks[22], (DEPTH, HG_DV), 0.02),
        "w_br_s5": nrm(ks[23], (DEPTH, S5_WIDTH, D_MODEL), S5_WIDTH ** -0.5),
        "w_br_hg": nrm(ks[24], (DEPTH, HG_VAL_WIDTH, D_MODEL), HG_VAL_WIDTH ** -0.5),
        "w_out": nrm(ks[25], (DEPTH, D_MODEL, D_MODEL), D_MODEL ** -0.5),
        "w_up": nrm(ks[26], (DEPTH, D_MODEL, D_FF), D_MODEL ** -0.5),
        "w_down": nrm(ks[27], (DEPTH, D_FF, D_MODEL), D_FF ** -0.5),
    }


def reference(x_prompt, x_sample, state_s5_re, state_s5_im, state_hg,
              norm_mix_pre, norm_mix_post, norm_mlp_pre, norm_mlp_post, w_in, b_in,
              s5_a_re, s5_a_im, s5_log_dt, s5_b_re, s5_b_im, s5_c_re, s5_c_im, s5_d, s5_w_glu, s5_b_glu,
              hg_lb_logits, hg_norm, w_br_s5, w_br_hg, w_out, w_up, w_down):
    lb_all = jnp.cumsum(jax.nn.softmax(hg_lb_logits.astype(f32), axis=0), axis=0)
    xp, xs = x_prompt, x_sample
    p_re, p_im, p_hg, s_re, s_im, s_hg = [], [], [], [], [], []
    for l in range(DEPTH):
        w = (norm_mix_pre[l], norm_mix_post[l], norm_mlp_pre[l], norm_mlp_post[l], w_in[l], b_in[l],
             s5_a_re[l], s5_a_im[l], s5_log_dt[l], s5_b_re[l], s5_b_im[l], s5_c_re[l], s5_c_im[l],
             s5_d[l], s5_w_glu[l], s5_b_glu[l], hg_norm[l], w_br_s5[l], w_br_hg[l], w_out[l],
             w_up[l], w_down[l])
        bsz = xp.shape[0]
        xp, r, im, hg = trunk_layer(xp,
                                    jnp.zeros((bsz, S5_GROUPS, S5_STATE), f32),
                                    jnp.zeros((bsz, S5_GROUPS, S5_STATE), f32),
                                    jnp.zeros((bsz, HG_HEADS, HG_DK, HG_DV), f32),
                                    lb_all[l], *w)
        p_re.append(r); p_im.append(im); p_hg.append(hg)
        xs, r, im, hg = trunk_layer(xs, state_s5_re[l], state_s5_im[l], state_hg[l], lb_all[l], *w)
        s_re.append(r); s_im.append(im); s_hg.append(hg)
    return (xp, xs, jnp.stack(p_re), jnp.stack(p_im), jnp.stack(p_hg),
            jnp.stack(s_re), jnp.stack(s_im), jnp.stack(s_hg))
```

```cpp
#include <hip/hip_runtime.h>
#include <cstdio>
#include <cstdint>
namespace pg8 {
#define PG8_LAS __attribute__((address_space(3)))
typedef unsigned short bf16_t;
typedef short bf16x8 __attribute__((ext_vector_type(8)));
typedef float f32x4 __attribute__((ext_vector_type(4)));
typedef unsigned u32x4 __attribute__((ext_vector_type(4)));
constexpr int BM = 256, BK = 64, HALF = 128, HTB = HALF * BK * 2  , STAGE_BYTES = 8 * HTB, NXCD = 8, WGM = 8;

__host__ __device__ __forceinline__ int lds_byte(int r, int c) { const int st = (r >> 4) * 2 + (c >> 5), rr = r & 15, cc = c & 31, ob = rr * 64 + cc * 2; return st * 1024 + (ob ^ (((ob >> 9) & 1) << 5)); }
__host__ __device__ __forceinline__ void stage_rc(int b, int& R, int& C) { const int st = b / 1024, sb = b % 1024, swz = sb ^ (((sb >> 9) & 1) << 5); R = (st >> 1) * 16 + swz / 64; C = (st & 1) * 32 + (swz % 64) / 2; }
__host__ __device__ __forceinline__ int perm32(int rho) { const int n = rho >> 4, i = rho & 15; return 8 * (i >> 2) + 4 * n + (i & 3); }

struct Unit { int pm, pn; };
struct Gemm { const bf16_t* A; const bf16_t* Bt; int M, N, K; };

struct StaticOrder {
    int nM, nN, nwg, G, c;
    __host__ __device__ void init(int M, int N, int G_, int c_) { nM = M / BM; nN = N / BM; nwg = nM * nN; G = G_; c = c_; }
    __host__ __device__ bool next(int i, Unit& u) const {
        const long L = (long)i * G + c; if (L >= nwg) return false;
        int wgid = (int)L; { const int q = nwg / NXCD, r = nwg % NXCD, xcd = wgid % NXCD, off = wgid / NXCD; wgid = (xcd < r ? xcd * (q + 1) : r * (q + 1) + (xcd - r) * q) + off; }
        const int nig = WGM * nN, gid = wgid / nig, fm = gid * WGM, gsz = (nM - fm) < WGM ? (nM - fm) : WGM;
        u.pm = fm + ((wgid % nig) % gsz); u.pn = (wgid % nig) / gsz; return true;
    }
    __device__ __forceinline__ void a_ready(const Unit&) const {}
    __device__ __forceinline__ void done(const Unit&) const {}
};

typedef float f32x2_t __attribute__((ext_vector_type(2))); typedef __bf16 bf16x2_t __attribute__((ext_vector_type(2)));
__device__ __forceinline__ unsigned cvt_pk_bf16(float lo, float hi) { const f32x2_t v = {lo, hi}; const bf16x2_t b = __builtin_convertvector(v, bf16x2_t); return __builtin_bit_cast(unsigned, b); }
typedef float f32x2 __attribute__((ext_vector_type(2)));
typedef unsigned u32x2 __attribute__((ext_vector_type(2)));
typedef _Float16 h16x2 __attribute__((ext_vector_type(2)));
__device__ __forceinline__ float bf2f(unsigned short b) { return __uint_as_float((unsigned)b << 16); }
__device__ __forceinline__ float bflo(unsigned w) { return __uint_as_float(w << 16); }
__device__ __forceinline__ float bfhi(unsigned w) { return __uint_as_float(w & 0xffff0000u); }
__device__ __forceinline__ float frcp(float x) { return __builtin_amdgcn_rcpf(x); }
__device__ __forceinline__ float sigm(float x) { return frcp(1.0f + __expf(-x)); }
__device__ __forceinline__ float siluf(float x) { return x * sigm(x); }
__device__ __forceinline__ float gelu_tanh(float x) { const float u = 0.7978845608028654f * (x + 0.044715f * x * x * x); return x * sigm(2.0f * u); }
__device__ __forceinline__ unsigned pk_f16(float lo, float hi) { h16x2 v = {(_Float16)lo, (_Float16)hi}; return __builtin_bit_cast(unsigned, v); }

struct EpiIn {
    static constexpr bool PERM = true, AFTER_DRAIN = false;
    bf16_t *U, *Q, *LF, *V, *G, *GS5, *GHG; const float* bias; const float* lbl;
    template <int TYPE> __device__ __forceinline__ void body(const f32x4 (&acc)[2][2][4][2], bf16_t* base, int ldc, int row0, int col0, int bcol0) const {
        f32x4 bv[2][2], lb[2][2];
#pragma unroll
        for (int bj = 0; bj < 2; ++bj)
#pragma unroll
            for (int n = 0; n < 2; ++n) { bv[bj][n] = *(const f32x4*)(bias + bcol0 + bj * HALF + 4 * n);
                if (TYPE == 2) { const f32x4 l0 = *(const f32x4*)(lbl + col0 + bj * HALF + 4 * n), l1 = *(const f32x4*)(lbl + 1024 + col0 + bj * HALF + 4 * n);
#pragma unroll
                    for (int e = 0; e < 4; ++e) lb[bj][n][e] = frcp(1.0f + __expf(l1[e] - l0[e])); } }
#pragma unroll
        for (int ai = 0; ai < 2; ++ai)
#pragma unroll
            for (int m = 0; m < 4; ++m) { bf16_t* rowp = base + (size_t)(row0 + ai * HALF + m * 16) * ldc + col0;
#pragma unroll
                for (int bj = 0; bj < 2; ++bj) { float v[8];
#pragma unroll
                    for (int e = 0; e < 4; ++e) { v[e] = acc[ai][bj][m][0][e] + bv[bj][0][e]; v[4 + e] = acc[ai][bj][m][1][e] + bv[bj][1][e]; }
                    u32x4 w;
                    if (TYPE == 2) {
#pragma unroll
                        for (int e = 0; e < 8; ++e) { const float l = lb[bj][e >> 2][e & 3]; v[e] = __logf(l + (1.0f - l) * sigm(v[e])); }
                        w.x = pk_f16(v[0], v[1]); w.y = pk_f16(v[2], v[3]); w.z = pk_f16(v[4], v[5]); w.w = pk_f16(v[6], v[7]);
                    } else {
#pragma unroll
                        for (int e = 0; e < 8; ++e) { if (TYPE == 1) v[e] = siluf(v[e]); if (TYPE == 3) v[e] = sigm(v[e]); }
                        w.x = cvt_pk_bf16(v[0], v[1]); w.y = cvt_pk_bf16(v[2], v[3]); w.z = cvt_pk_bf16(v[4], v[5]); w.w = cvt_pk_bf16(v[6], v[7]);
                    }
                    *(u32x4*)(rowp + bj * HALF) = w; } }
    }
    __device__ __forceinline__ void operator()(const f32x4 (&acc)[2][2][4][2], const Unit& u, int wr, int wc, int fr, int fq) const {
        const int row0 = u.pm * BM + wr * 64 + fr, bcol0 = u.pn * BM + wc * 32 + 8 * fq;
        if (u.pn < 2) { body<0>(acc, U, 512, row0, u.pn * BM + wc * 32 + 8 * fq, bcol0); return; }
        const int s = (u.pn - 2) >> 2, col0 = ((u.pn - 2) & 3) * BM + wc * 32 + 8 * fq;
        if (s == 0) body<1>(acc, Q, 1024, row0, col0, bcol0);
        else if (s == 1) body<2>(acc, LF, 1024, row0, col0, bcol0);
        else if (s == 2) body<0>(acc, V, 1024, row0, col0, bcol0);
        else if (s == 3) body<1>(acc, G, 1024, row0, col0, bcol0);
        else if (s == 4) body<3>(acc, GS5, 1024, row0, col0, bcol0);
        else body<3>(acc, GHG, 1024, row0, col0, bcol0);
    }
};
template <int MODE> struct EpiElem {
    static constexpr bool PERM = true, AFTER_DRAIN = false;
    bf16_t* O; const bf16_t* P; int ldc; const float* bias;
    __device__ __forceinline__ void operator()(const f32x4 (&acc)[2][2][4][2], const Unit& u, int wr, int wc, int fr, int fq) const {
        const int row0 = u.pm * BM + wr * 64 + fr, col0 = u.pn * BM + wc * 32 + 8 * fq;
        f32x4 bv[2][2];
        if (MODE == 0) {
#pragma unroll
            for (int bj = 0; bj < 2; ++bj)
#pragma unroll
                for (int n = 0; n < 2; ++n) bv[bj][n] = *(const f32x4*)(bias + col0 + bj * HALF + 4 * n); }
#pragma unroll
        for (int ai = 0; ai < 2; ++ai)
#pragma unroll
            for (int m = 0; m < 4; ++m) { const size_t off = (size_t)(row0 + ai * HALF + m * 16) * ldc + col0;
#pragma unroll
                for (int bj = 0; bj < 2; ++bj) { float v[8];
#pragma unroll
                    for (int e = 0; e < 4; ++e) { v[e] = acc[ai][bj][m][0][e]; v[4 + e] = acc[ai][bj][m][1][e]; }
                    if (MODE == 0) {
#pragma unroll
                        for (int e = 0; e < 8; ++e) v[e] = sigm(v[e] + bv[bj][e >> 2][e & 3]); }
                    if (MODE == 3) {
#pragma unroll
                        for (int e = 0; e < 8; ++e) { const float r = fmaxf(v[e], 0.0f); v[e] = r * r; } }
                    if (MODE <= 2) { const u32x4 p = *(const u32x4*)(P + off + bj * HALF);
                        v[0] *= bflo(p.x); v[1] *= bfhi(p.x); v[2] *= bflo(p.y); v[3] *= bfhi(p.y); v[4] *= bflo(p.z); v[5] *= bfhi(p.z); v[6] *= bflo(p.w); v[7] *= bfhi(p.w); }
                    if (MODE == 2) { const u32x4 o = *(const u32x4*)(O + off + bj * HALF);
                        v[0] += bflo(o.x); v[1] += bfhi(o.x); v[2] += bflo(o.y); v[3] += bfhi(o.y); v[4] += bflo(o.z); v[5] += bfhi(o.z); v[6] += bflo(o.w); v[7] += bfhi(o.w); }
                    u32x4 w; w.x = cvt_pk_bf16(v[0], v[1]); w.y = cvt_pk_bf16(v[2], v[3]); w.z = cvt_pk_bf16(v[4], v[5]); w.w = cvt_pk_bf16(v[6], v[7]);
                    *(u32x4*)(O + off + bj * HALF) = w; } }
    }
};
struct EpiRaw {
    static constexpr bool PERM = false, AFTER_DRAIN = false;
    float* O; int ldc;
    __device__ __forceinline__ void operator()(const f32x4 (&acc)[2][2][4][2], const Unit& u, int wr, int wc, int fr, int fq) const {
        const int row0 = u.pm * BM + wr * 64 + fr, col0 = u.pn * BM + wc * 32 + 4 * fq;
#pragma unroll
        for (int ai = 0; ai < 2; ++ai)
#pragma unroll
            for (int m = 0; m < 4; ++m) { float* rowp = O + (size_t)(row0 + ai * HALF + m * 16) * ldc + col0;
#pragma unroll
                for (int bj = 0; bj < 2; ++bj)
#pragma unroll
                    for (int n = 0; n < 2; ++n) *(f32x4*)(rowp + bj * HALF + n * 16) = acc[ai][bj][m][n]; }
    }
};
template <class Epi, class Sched, bool ALIGN_EPI = false, bool SP2 = false>
__device__ __forceinline__ void gemm_phase(PG8_LAS unsigned char* lds, const Gemm g, const Sched& S, const Epi& E) {
    const int tid = threadIdx.x, wid = __builtin_amdgcn_readfirstlane(tid >> 6), lane = tid & 63, wr = wid >> 2, wc = wid & 3, fr = lane & 15, fq = lane >> 4;
    const int K = g.K, nt = K / BK;
    unsigned voffA[2], voffB[2];
#pragma unroll
    for (int i = 0; i < 2; ++i) { int R, C; stage_rc(tid * 16 + i * 8192, R, C); const int Rb = Epi::PERM ? ((R & ~31) + perm32(R & 31)) : R;
        voffA[i] = (unsigned)(R * K + C) * 2u; voffB[i] = (unsigned)(Rb * K + C) * 2u; }
    const size_t kstep = (size_t)(BK * 2);
    const size_t hstep = (size_t)HALF * K * 2;
    const size_t tstep = 2 * hstep;
    const unsigned ldsw = (unsigned)wid * 1024u;
    const int aoff = lds_byte(wr * 64 + fr, fq * 8), boff = lds_byte(wc * 32 + fr, fq * 8);
#define PG8_SA(b, h) (((b) * 2 + (h)) * HTB)
#define PG8_SB(b, h) ((4 + (b) * 2 + (h)) * HTB)
#define PG8_STAGE(bufoff, gbase, voff) do { _Pragma("unroll") for (int _i = 0; _i < 2; ++_i) \
        __builtin_amdgcn_global_load_lds((const unsigned*)((const char*)(gbase) + (voff)[_i]), (PG8_LAS unsigned*)(lds + (bufoff) + ldsw + _i * 8192), 16, 0, 0); } while (0)
#define PG8_LDA(dst, b, h) do { _Pragma("unroll") for (int m = 0; m < 4; ++m) _Pragma("unroll") for (int k = 0; k < 2; ++k) dst[m][k] = *(const PG8_LAS bf16x8*)(lds + PG8_SA(b, h) + aoff + m * 2048 + k * 1024); } while (0)
#define PG8_LDB(dst, b, h) do { _Pragma("unroll") for (int n = 0; n < 2; ++n) _Pragma("unroll") for (int k = 0; k < 2; ++k) dst[n][k] = *(const PG8_LAS bf16x8*)(lds + PG8_SB(b, h) + boff + n * 2048 + k * 1024); } while (0)
#define PG8_MMA(ai, bj, At, Bt) do { __builtin_amdgcn_s_setprio(1); _Pragma("unroll") for (int m = 0; m < 4; ++m) _Pragma("unroll") for (int n = 0; n < 2; ++n) _Pragma("unroll") for (int k = 0; k < 2; ++k) \
        acc[ai][bj][m][n] = __builtin_amdgcn_mfma_f32_16x16x32_bf16(Bt[n][k], At[m][k], acc[ai][bj][m][n], 0, 0, 0); __builtin_amdgcn_s_setprio(0); } while (0)
#define PG8_WAIT_V(n) asm volatile("s_waitcnt vmcnt(" #n ")" ::: "memory")
#define PG8_WAIT_L(n) asm volatile("s_waitcnt lgkmcnt(" #n ")" ::: "memory")
#define PG8_BAR __builtin_amdgcn_s_barrier()
#define PG8_SCHED __builtin_amdgcn_sched_barrier(0)
    Unit cur, nxt; int ui = 0;
    if (!S.next(0, cur)) return;
    f32x4 acc[2][2][4][2];
#pragma unroll
    for (int a = 0; a < 2; ++a)
#pragma unroll
        for (int b = 0; b < 2; ++b)
#pragma unroll
            for (int m = 0; m < 4; ++m)
#pragma unroll
                for (int n = 0; n < 2; ++n) acc[a][b][m][n] = (f32x4){0.f, 0.f, 0.f, 0.f};
    bf16x8 At[4][2], B0[2][2], B1[2][2];
    const char* cA = (const char*)g.A + (size_t)cur.pm * tstep; const char* cB = (const char*)g.Bt + (size_t)cur.pn * tstep;
    S.a_ready(cur);
    if constexpr (SP2) {
        PG8_STAGE(PG8_SB(0, 0), cB, voffB); PG8_STAGE(PG8_SB(0, 1), cB + hstep, voffB); PG8_STAGE(PG8_SA(0, 0), cA, voffA); PG8_STAGE(PG8_SA(0, 1), cA + hstep, voffA);
        if (wr == 1) PG8_BAR;
        PG8_WAIT_V(2); PG8_BAR;
        PG8_STAGE(PG8_SB(1, 0), cB + kstep, voffB); PG8_STAGE(PG8_SA(1, 0), cA + kstep, voffA); PG8_STAGE(PG8_SB(1, 1), cB + hstep + kstep, voffB);
        PG8_WAIT_V(6); PG8_BAR;
    } else {
        PG8_STAGE(PG8_SB(0, 0), cB, voffB); PG8_STAGE(PG8_SA(0, 0), cA, voffA); PG8_STAGE(PG8_SB(0, 1), cB + hstep, voffB); PG8_STAGE(PG8_SA(0, 1), cA + hstep, voffA);
        if (wr == 1) PG8_BAR;
        PG8_WAIT_V(4); PG8_BAR;
        PG8_STAGE(PG8_SB(1, 0), cB + kstep, voffB); PG8_STAGE(PG8_SA(1, 0), cA + kstep, voffA); PG8_STAGE(PG8_SB(1, 1), cB + hstep + kstep, voffB);
        PG8_WAIT_V(6); PG8_BAR;
    }
    for (;;) {
        const bool has_next = S.next(ui + 1, nxt);
        const char* nA = has_next ? (const char*)g.A + (size_t)nxt.pm * tstep : cA; const char* nB = has_next ? (const char*)g.Bt + (size_t)nxt.pn * tstep : cB;
        for (int t = 0; t < nt; t += 2) {
            const bool last = (t == nt - 2);
            const char* a1 = cA + (size_t)(t + 1) * kstep;
            const char* a2 = last ? nA : cA + (size_t)(t + 2) * kstep; const char* b2 = last ? nB : cB + (size_t)(t + 2) * kstep;
            const char* a3 = a2 + kstep; const char* b3 = b2 + kstep;
            if (last && has_next) S.a_ready(nxt);
            if constexpr (SP2) {
            PG8_LDB(B0, 0, 0); PG8_LDB(B1, 0, 1); PG8_SCHED; PG8_LDA(At, 0, 0); PG8_STAGE(PG8_SA(1, 1), a1 + hstep, voffA);
            PG8_WAIT_V(8); PG8_WAIT_L(0); PG8_BAR; PG8_MMA(0, 0, At, B0); PG8_MMA(0, 1, At, B1); PG8_BAR; PG8_SCHED;
            PG8_LDA(At, 0, 1); PG8_STAGE(PG8_SB(0, 0), b2, voffB); PG8_STAGE(PG8_SB(0, 1), b2 + hstep, voffB); PG8_STAGE(PG8_SA(0, 0), a2, voffA);
            PG8_WAIT_V(8); PG8_WAIT_L(0); PG8_BAR; PG8_MMA(1, 0, At, B0); PG8_MMA(1, 1, At, B1); PG8_BAR; PG8_SCHED;
            PG8_LDB(B0, 1, 0); PG8_LDB(B1, 1, 1); PG8_SCHED; PG8_LDA(At, 1, 0); PG8_STAGE(PG8_SA(0, 1), a2 + hstep, voffA);
            PG8_WAIT_V(8); PG8_WAIT_L(0); PG8_BAR; PG8_MMA(0, 0, At, B0); PG8_MMA(0, 1, At, B1); PG8_BAR; PG8_SCHED;
            PG8_LDA(At, 1, 1); PG8_STAGE(PG8_SB(1, 0), b3, voffB); PG8_STAGE(PG8_SB(1, 1), b3 + hstep, voffB); PG8_STAGE(PG8_SA(1, 0), a3, voffA);
            PG8_WAIT_V(8); PG8_WAIT_L(0); PG8_BAR; PG8_MMA(1, 0, At, B0); PG8_MMA(1, 1, At, B1); PG8_BAR; PG8_SCHED;
            } else {
            PG8_LDB(B0, 0, 0); PG8_SCHED; PG8_LDA(At, 0, 0); PG8_STAGE(PG8_SA(1, 1), a1 + hstep, voffA);
            PG8_WAIT_L(8); PG8_BAR; PG8_WAIT_L(0); PG8_MMA(0, 0, At, B0); PG8_BAR; PG8_SCHED;
            PG8_LDB(B1, 0, 1); PG8_STAGE(PG8_SB(0, 0), b2, voffB);
            PG8_BAR; PG8_WAIT_L(0); PG8_MMA(0, 1, At, B1); PG8_BAR;
            PG8_LDA(At, 0, 1); PG8_STAGE(PG8_SA(0, 0), a2, voffA);
            PG8_BAR; PG8_WAIT_L(0); PG8_MMA(1, 0, At, B0); PG8_BAR; PG8_SCHED;
            PG8_STAGE(PG8_SB(0, 1), b2 + hstep, voffB);
            PG8_WAIT_V(6); PG8_BAR; PG8_MMA(1, 1, At, B1); PG8_BAR;
            PG8_LDB(B0, 1, 0); PG8_SCHED; PG8_LDA(At, 1, 0); PG8_STAGE(PG8_SA(0, 1), a2 + hstep, voffA);
            PG8_WAIT_L(8); PG8_BAR; PG8_WAIT_L(0); PG8_MMA(0, 0, At, B0); PG8_BAR; PG8_SCHED;
            PG8_LDB(B1, 1, 1); PG8_STAGE(PG8_SB(1, 0), b3, voffB);
            PG8_BAR; PG8_WAIT_L(0); PG8_MMA(0, 1, At, B1); PG8_BAR;
            PG8_LDA(At, 1, 1); PG8_STAGE(PG8_SA(1, 0), a3, voffA);
            PG8_BAR; PG8_WAIT_L(0); PG8_MMA(1, 0, At, B0); PG8_BAR; PG8_SCHED;
            PG8_STAGE(PG8_SB(1, 1), b3 + hstep, voffB);
            PG8_WAIT_V(6); PG8_BAR; PG8_MMA(1, 1, At, B1); PG8_BAR;
            }
        }
        if constexpr (ALIGN_EPI) { if (wr == 0) PG8_BAR; }
        if constexpr (!Epi::AFTER_DRAIN) { E(acc, cur, wr, wc, fr, fq); S.done(cur); }
        if (!has_next) break;
#pragma unroll
        for (int a = 0; a < 2; ++a)
#pragma unroll
            for (int b = 0; b < 2; ++b)
#pragma unroll
                for (int m = 0; m < 4; ++m)
#pragma unroll
                    for (int n = 0; n < 2; ++n) acc[a][b][m][n] = (f32x4){0.f, 0.f, 0.f, 0.f};
        cur = nxt; cA = nA; cB = nB; ++ui;
        if constexpr (ALIGN_EPI) { if (wr == 1) PG8_BAR; }
    }
    PG8_WAIT_V(0);
    if constexpr (!ALIGN_EPI) { if (wr == 0) PG8_BAR; }
    PG8_BAR;
    if constexpr (Epi::AFTER_DRAIN) { E.fused(acc, cur, wr, wc, fr, fq, lds, wid, lane); S.done(cur); }
#undef PG8_SA
#undef PG8_SB
#undef PG8_STAGE
#undef PG8_LDA
#undef PG8_LDB
#undef PG8_MMA
#undef PG8_WAIT_V
#undef PG8_WAIT_L
#undef PG8_BAR
#undef PG8_SCHED
}
}

#define DI __device__ __forceinline__
constexpr int NWAVES = 8;
#ifndef MK_N_LAUNCHES
#define MK_N_LAUNCHES 1
#endif
constexpr int N_PHASES = 10;
constexpr int N_LAUNCHES = MK_N_LAUNCHES;
constexpr int D = 1024, MP = 16384, MS = 512, M = MP + MS, NIN = 6656, FF = 4096, S5W = 512;
constexpr int SEQ = 2048, NB = 8, DB = 128, DSEQ = 4;
constexpr int SG = 32, SN = 64, SC = 16;
constexpr int HH = 8, DK = 128, DV = 128;
constexpr float EPS = 1e-6f;
constexpr size_t O_Y = 0, O_S5RP = (size_t)M * D, O_S5IP = O_S5RP + NB * SG * SN, O_HGP = O_S5IP + NB * SG * SN, O_S5RS = O_HGP + (size_t)NB * HH * DK * DV,
                 O_S5IS = O_S5RS + (size_t)DB * SG * SN, O_HGS = O_S5IS + (size_t)DB * SG * SN, O_END = O_HGS + (size_t)DB * HH * DK * DV;
constexpr size_t MiB = 1u << 20, HMiB = 1u << 19;
constexpr size_t WS_CTL = 0, CTL_ZERO_BYTES = 1 * MiB;
constexpr size_t WS_WIN = 1 * MiB, WS_WGLU = 14 * MiB, WS_WBRS = 14 * MiB + HMiB, WS_WBRH = 15 * MiB + HMiB, WS_WOUT = 17 * MiB + HMiB, WS_WUP = 19 * MiB + HMiB, WS_WDN = 27 * MiB + HMiB;
constexpr size_t WS_KC = 35 * MiB + HMiB, WS_VOUT = 36 * MiB, WS_WEND = 38 * MiB, WS_WEND4 = 40 * MiB, WS_APOW = 40 * MiB + HMiB;
constexpr size_t WS_XN = 41 * MiB, WS_U = 74 * MiB, WS_S0 = 90 * MiB + HMiB, WS_S1 = WS_S0 + 33 * MiB, WS_S2 = WS_S1 + 33 * MiB, WS_S3 = WS_S2 + 33 * MiB;
constexpr size_t WS_YG = WS_XN, WS_YS5 = WS_XN + 16 * MiB + HMiB, WS_RAW1 = WS_S0, WS_YH = WS_S3 + 33 * MiB, WS_HMID = WS_XN, WS_RAW2 = 173 * MiB, WS_END = 256 * MiB;
static_assert((size_t)M * D * 2 == 33 * MiB && WS_S3 + 33 * MiB <= WS_END && WS_HMID + (size_t)M * FF * 2 <= WS_S3 && WS_RAW2 + (size_t)M * D * 4 <= WS_END && WS_RAW2 >= WS_HMID + (size_t)M * FF * 2, "d_ws map");
constexpr int CW_TMO = 0, CW_CODE = 1, CW_BAR = 4096;
constexpr int RING_BYTES = 131072, LDSCTL_OFF = RING_BYTES, MISC_OFF = LDSCTL_OFF + 320, LDS_BYTES = 147456;

#define GAS __attribute__((address_space(1)))
#define LAS __attribute__((address_space(3)))
typedef unsigned short bf16;
typedef unsigned v4u __attribute__((ext_vector_type(4)));
typedef float f32x4 __attribute__((ext_vector_type(4)));
typedef short bf16x8 __attribute__((ext_vector_type(8)));
typedef GAS unsigned gu32;
typedef GAS unsigned long long gu64;
#define RLX_AGENT __ATOMIC_RELAXED, __HIP_MEMORY_SCOPE_AGENT
#define LDS_WAIT() asm volatile("s_waitcnt lgkmcnt(0)" ::: "memory")
#define VM_WAIT() asm volatile("s_waitcnt vmcnt(0)" ::: "memory")
__device__ __forceinline__ unsigned long long rt() { return __builtin_amdgcn_s_memrealtime(); }
__device__ __forceinline__ unsigned f2bf(float f) { unsigned u = __builtin_bit_cast(unsigned, f); return (u + 0x7fffu + ((u >> 16) & 1u)) >> 16; }
__device__ __forceinline__ unsigned pk2(float lo, float hi) { return f2bf(lo) | (f2bf(hi) << 16); }
#define XB_TMO      128
#define XB_XCNT(j)  (256  + 64 * (j))
#define XB_XSUB(j)  (1280 + 64 * (j))
#define XB_XGEN(j)  (2304 + 64 * (j))
#define XB_TOP      3328
#define XB_TOPGEN   3392
#define XCD_BAR_WORDS 3456
#define XB_SPIN_CAP (1u << 18)

__device__ __forceinline__ unsigned xb_ld(unsigned* p)              { return __hip_atomic_load(p, __ATOMIC_RELAXED, __HIP_MEMORY_SCOPE_AGENT); }
__device__ __forceinline__ unsigned xb_add(unsigned* p, unsigned v) { return __hip_atomic_fetch_add(p, v, __ATOMIC_RELAXED, __HIP_MEMORY_SCOPE_AGENT); }
__device__ __forceinline__ unsigned xb_xcc_id() { return (unsigned)__builtin_amdgcn_s_getreg((3 << 11) | 20) & 0xFu; }
#define XB_SPIN(cond, bar) do { unsigned _sp = 0; while (cond) { __builtin_amdgcn_s_sleep(1); \
    if ((++_sp & 255u) == 0u) { if (xb_ld(&(bar)[XB_TMO])) break; if (_sp > XB_SPIN_CAP) { atomicAdd(&(bar)[XB_TMO], 1u); break; } } } } while (0)

struct XcdBarrier {
    unsigned* bar; unsigned x;
    volatile LAS unsigned* st;
};

__device__ __forceinline__ XcdBarrier xcd_barrier_post(unsigned* bar, volatile LAS unsigned* st) {
    XcdBarrier b; b.bar = bar; b.x = xb_xcc_id(); b.st = st;
    if (threadIdx.x == 0) (void)xb_add(&bar[XB_XCNT(b.x)], 1u);
    return b;
}
__device__ __forceinline__ void xcd_barrier_complete(unsigned* bar, unsigned x, unsigned& nloc, unsigned& nx) {
    const unsigned G = gridDim.x * gridDim.y * gridDim.z;
    unsigned sum, cnt, mine, sp = 0u;
    for (;;) {
        sum = 0u; cnt = 0u; mine = 0u;
#pragma unroll
        for (unsigned j = 0; j < 16; ++j) { const unsigned c = xb_ld(&bar[XB_XCNT(j)]); sum += c; cnt += (c > 0u) ? 1u : 0u; mine = (j == x) ? c : mine; }
        if (sum == G) break;
        __builtin_amdgcn_s_sleep(1);
        if ((++sp & 255u) == 0u) { if (xb_ld(&bar[XB_TMO])) break; if (sp > XB_SPIN_CAP) { atomicAdd(&bar[XB_TMO], 1u); break; } }
    }
    nloc = mine > 0u ? mine : 1u; nx = cnt > 0u ? cnt : 1u;
}

__device__ __forceinline__ void xcd_barrier(const XcdBarrier& b) {
    asm volatile("s_waitcnt vmcnt(0)" ::: "memory");
    __syncthreads();
    if (threadIdx.x == 0) {
        unsigned* bar = b.bar;
        __builtin_amdgcn_s_waitcnt(0);
        unsigned nloc = b.st[0], nx = b.st[1];
        if (nloc == 0u) { xcd_barrier_complete(bar, b.x, nloc, nx); b.st[0] = nloc; b.st[1] = nx; }
        const unsigned old = xb_add(&bar[XB_XSUB(b.x)], 1u);
        const unsigned gen = old / nloc;
        if (old + 1u == (gen + 1u) * nloc) {
            __builtin_amdgcn_fence(__ATOMIC_RELEASE, "agent");
            asm volatile("s_waitcnt vmcnt(0)" ::: "memory");
            const unsigned og = xb_add(&bar[XB_TOP], 1u);
            const unsigned tg = og / nx;
            if (og + 1u == (tg + 1u) * nx) xb_add(&bar[XB_TOPGEN], 1u);
            else XB_SPIN(xb_ld(&bar[XB_TOPGEN]) == tg, bar);
            __builtin_amdgcn_fence(__ATOMIC_ACQUIRE, "agent");
            xb_add(&bar[XB_XGEN(b.x)], 1u);
            asm volatile("s_waitcnt vmcnt(0)" ::: "memory");
        } else {
            XB_SPIN(xb_ld(&bar[XB_XGEN(b.x)]) == gen, bar);
            __builtin_amdgcn_fence(__ATOMIC_ACQUIRE, "agent");
            asm volatile("s_waitcnt vmcnt(0)" ::: "memory");
        }
    }
    __syncthreads();
}

typedef short s16x4 __attribute__((ext_vector_type(4)));
typedef float f32x16 __attribute__((ext_vector_type(16)));
typedef unsigned v2u __attribute__((ext_vector_type(2)));
using pg8::bf2f; using pg8::bflo; using pg8::bfhi; using pg8::sigm; using pg8::siluf; using pg8::gelu_tanh; using pg8::frcp; using pg8::cvt_pk_bf16;
#define MFMA32(a, b, c) __builtin_amdgcn_mfma_f32_32x32x16_bf16((a), (b), (c), 0, 0, 0)
#define MFMA16(a, b, c) __builtin_amdgcn_mfma_f32_16x16x32_bf16((a), (b), (c), 0, 0, 0)
struct Frame {
    LAS unsigned char* lds; volatile LAS unsigned* MISC; gu32* ctl;
    int tid, lane, wave, vcu, G;
    const float* in[28]; float* out; unsigned char* ws;
};
DI float wave_sum(float v) {
#pragma unroll
    for (int o = 1; o < 64; o <<= 1) v += __shfl_xor(v, o);
    return v;
}
DI const float* xrow(const Frame& F, int m) { return m < MP ? F.in[0] + (size_t)m * D : F.in[1] + (size_t)(m - MP) * D; }
DI bf16x8 zero8() { return (bf16x8){0, 0, 0, 0, 0, 0, 0, 0}; }
DI f32x16 zero16() { f32x16 z;
#pragma unroll
    for (int i = 0; i < 16; ++i) z[i] = 0.f;
    return z; }
DI bf16x8 ldg8(const bf16* p) { return *(const GAS bf16x8*)p; }
DI bf16x8 pack8(float a0, float a1, float a2, float a3, float a4, float a5, float a6, float a7) {
    v4u w; w.x = cvt_pk_bf16(a0, a1); w.y = cvt_pk_bf16(a2, a3); w.z = cvt_pk_bf16(a4, a5); w.w = cvt_pk_bf16(a6, a7); return __builtin_bit_cast(bf16x8, w); }

DI void p0_transpose_item(const float* W, int K, int N, bf16* WT, LAS float* scr, int item, int lane) {
    const int nblk = N / 32, kb = item / nblk, nb = item % nblk, k0 = 64 * kb, n0 = 32 * nb;
#pragma unroll 8
    for (int i = 0; i < 32; ++i) { const int kk = 2 * i + (lane >> 5); scr[kk * 33 + (lane & 31)] = W[(size_t)(k0 + kk) * N + n0 + (lane & 31)]; }
    LDS_WAIT(); asm volatile("" ::: "memory");
    const int c = lane & 7;
#pragma unroll
    for (int j = 0; j < 4; ++j) { const int n = (lane >> 3) + 8 * j; const LAS float* s = scr + (8 * c) * 33 + n;
        v4u o; o.x = pk2(s[0 * 33], s[1 * 33]); o.y = pk2(s[2 * 33], s[3 * 33]); o.z = pk2(s[4 * 33], s[5 * 33]); o.w = pk2(s[6 * 33], s[7 * 33]);
        *(GAS v4u*)(WT + (size_t)(n0 + n) * K + k0 + 8 * c) = o; }
    LDS_WAIT(); asm volatile("" ::: "memory");
}
DI void rms_row_to_bf16(const Frame& F, const float* xr_, const float* g, bf16* orow) {
    const GAS f32x4* xr = (const GAS f32x4*)xr_ + F.lane; const GAS f32x4* gr = (const GAS f32x4*)g + F.lane;
    f32x4 v[4]; float s = 0.f;
#pragma unroll
    for (int j = 0; j < 4; ++j) { v[j] = xr[64 * j]; s += (v[j].x * v[j].x + v[j].y * v[j].y) + (v[j].z * v[j].z + v[j].w * v[j].w); }
    const float rstd = 1.f / sqrtf(wave_sum(s) * (1.f / D) + EPS);
    GAS unsigned long long* o8 = (GAS unsigned long long*)orow + F.lane;
#pragma unroll
    for (int j = 0; j < 4; ++j) { const f32x4 gg = gr[64 * j];
        o8[64 * j] = (unsigned long long)pk2(v[j].x * rstd * gg.x, v[j].y * rstd * gg.y) | ((unsigned long long)pk2(v[j].z * rstd * gg.z, v[j].w * rstd * gg.w) << 32); }
}
DI void p0_s5_item(Frame& F, int g, int j) {
    LAS float* L = (LAS float*)F.lds;
    LAS float* PW = L; LAS float* BB = L + 1024;
    const float* a_re = F.in[11]; const float* a_im = F.in[12]; const float* log_dt = F.in[13];
    const float* b_re = F.in[14]; const float* b_im = F.in[15]; const float* c_re = F.in[16]; const float* c_im = F.in[17];
    const int tid = F.tid;
    if (tid < 64) { const int n = tid; const float are = a_re[g * SN + n], aim = a_im[g * SN + n], dt = expf(log_dt[g]);
        float sn, cs, sh, ch; sincosf(dt * aim, &sn, &cs); sincosf(0.5f * dt * aim, &sh, &ch);
        const float mag = expf(dt * are), abi = mag * sn;
        const float nr = expm1f(dt * are) - 2.0f * mag * sh * sh, ni = abi, den = are * are + aim * aim;
        PW[2 * n] = (nr * are + ni * aim) / den; PW[2 * n + 1] = (ni * are - nr * aim) / den;
        const int e4 = j < 4 ? 3 - j : 0; const int ex[4] = {j, j + 1, 15 - j, e4};
#pragma unroll
        for (int q = 0; q < 4; ++q) { float s2, c2; const float m2 = expf((float)ex[q] * dt * are); sincosf((float)ex[q] * dt * aim, &s2, &c2);
            PW[128 * (q + 1) + 2 * n] = m2 * c2; PW[128 * (q + 1) + 2 * n + 1] = m2 * s2; }
        if (j == 0) { float s4, c4; const float m4 = expf(4.0f * dt * are); sincosf(4.0f * dt * aim, &s4, &c4); ((float*)(F.ws + WS_APOW))[2 * (g * SN + n)] = m4 * c4; ((float*)(F.ws + WS_APOW))[2 * (g * SN + n) + 1] = m4 * s4; }
    }
    __syncthreads();
    for (int e = tid; e < SN * SC; e += NWAVES * 64) { const int n = e >> 4; const float cr = PW[2 * n], ci = PW[2 * n + 1], br = b_re[(size_t)g * SN * SC + e], bi = b_im[(size_t)g * SN * SC + e];
        BB[2 * e] = cr * br - ci * bi; BB[2 * e + 1] = cr * bi + ci * br; }
    __syncthreads();
    bf16* KC = (bf16*)(F.ws + WS_KC); bf16* VO = (bf16*)(F.ws + WS_VOUT); bf16* WE = (bf16*)(F.ws + WS_WEND); bf16* W4 = (bf16*)(F.ws + WS_WEND4);
    if (tid < 256) { const int co = tid >> 4, ci = tid & 15; float acc = 0.f;
        for (int n = 0; n < SN; ++n) { const float cr = c_re[((size_t)g * SC + co) * SN + n], cim = c_im[((size_t)g * SC + co) * SN + n];
            const float ar = PW[128 + 2 * n], ai = PW[128 + 2 * n + 1], br = BB[2 * (n * 16 + ci)], bi = BB[2 * (n * 16 + ci) + 1];
            const float xr = ar * br - ai * bi, xi = ar * bi + ai * br; acc += cr * xr - cim * xi; }
        KC[(((size_t)g * 16 + j) * 16 + co) * 16 + ci] = (bf16)f2bf(acc); }
    for (int e = tid; e < 16 * 128; e += NWAVES * 64) { const int co = e >> 7, np = e & 127, n = np & 63;
        const float cr = c_re[((size_t)g * SC + co) * SN + n], cim = c_im[((size_t)g * SC + co) * SN + n], ar = PW[256 + 2 * n], ai = PW[256 + 2 * n + 1];
        const float v = np < 64 ? (cr * ar - cim * ai) : -(cr * ai + cim * ar);
        VO[(((size_t)g * 16 + j) * 16 + co) * 128 + np] = (bf16)f2bf(v); }
    for (int e = tid; e < 128 * 16; e += NWAVES * 64) { const int np = e >> 4, ci = e & 15, n = np & 63;
        const float br = BB[2 * (n * 16 + ci)], bi = BB[2 * (n * 16 + ci) + 1];
        { const float ar = PW[384 + 2 * n], ai = PW[384 + 2 * n + 1]; const float v = np < 64 ? (ar * br - ai * bi) : (ar * bi + ai * br);
          WE[((size_t)g * 128 + np) * 256 + j * 16 + ci] = (bf16)f2bf(v); }
        if (j < 4) { const float ar = PW[512 + 2 * n], ai = PW[512 + 2 * n + 1]; const float v = np < 64 ? (ar * br - ai * bi) : (ar * bi + ai * br);
          W4[((size_t)g * 128 + np) * 64 + j * 16 + ci] = (bf16)f2bf(v); } }
    __syncthreads();
}
DI void p0_prologue(Frame& F) {
    for (int it = F.vcu; it < SG * 16; it += F.G) p0_s5_item(F, it >> 4, it & 15);
    LAS float* scr = (LAS float*)(F.lds + F.wave * 16384);
    const int gw = F.vcu * NWAVES + F.wave, NGW = F.G * NWAVES;
    constexpr int I_IN = (D / 64) * (NIN / 32), I_GLU = (S5W / 64) * (S5W / 32), I_BRS = (S5W / 64) * (D / 32), I_BRH = (D / 64) * (D / 32), I_OUT = I_BRH, I_UP = (D / 64) * (FF / 32), I_DN = (FF / 64) * (D / 32);
    constexpr int NITEMS = I_IN + I_GLU + I_BRS + I_BRH + I_OUT + I_UP + I_DN;
    for (int it = gw; it < NITEMS; it += NGW) {
        int r = it;
        if (r < I_IN) { p0_transpose_item(F.in[9], D, NIN, (bf16*)(F.ws + WS_WIN), scr, r, F.lane); continue; } r -= I_IN;
        if (r < I_GLU) { p0_transpose_item(F.in[19], S5W, S5W, (bf16*)(F.ws + WS_WGLU), scr, r, F.lane); continue; } r -= I_GLU;
        if (r < I_BRS) { p0_transpose_item(F.in[23], S5W, D, (bf16*)(F.ws + WS_WBRS), scr, r, F.lane); continue; } r -= I_BRS;
        if (r < I_BRH) { p0_transpose_item(F.in[24], D, D, (bf16*)(F.ws + WS_WBRH), scr, r, F.lane); continue; } r -= I_BRH;
        if (r < I_OUT) { p0_transpose_item(F.in[25], D, D, (bf16*)(F.ws + WS_WOUT), scr, r, F.lane); continue; } r -= I_OUT;
        if (r < I_UP) { p0_transpose_item(F.in[26], D, FF, (bf16*)(F.ws + WS_WUP), scr, r, F.lane); continue; } r -= I_UP;
        p0_transpose_item(F.in[27], FF, D, (bf16*)(F.ws + WS_WDN), scr, r, F.lane);
    }
    bf16* XN = (bf16*)(F.ws + WS_XN);
    for (int m = gw; m < M; m += NGW) rms_row_to_bf16(F, xrow(F, m), F.in[5], XN + (size_t)m * D);
}
constexpr int S5_HEND = 0, S5_HC = 128 * 132 * 4, S5_E = S5_HC + 128 * 136 * 2;
DI float gelu_du(float acc, float d, float u) { return gelu_tanh(acc + d * u); }
DI void s5_y_store(const Frame& F, const f32x16& acc, int g, int tok0, int t0, int h) {
    const bf16* U = (const bf16*)(F.ws + WS_U); bf16* YG = (bf16*)(F.ws + WS_YG); const float* dvec = F.in[18];
#pragma unroll
    for (int rq = 0; rq < 4; ++rq) { const int tl = rq >> 1, ch = g * SC + 8 * (rq & 1) + 4 * h; const size_t off = (size_t)(tok0 + t0 + tl) * S5W + ch;
        const v2u uu = *(const GAS v2u*)(U + off); const f32x4 dd = *(const GAS f32x4*)(dvec + ch);
        const float y0 = gelu_du(acc[4 * rq + 0], dd.x, bflo(uu.x)), y1 = gelu_du(acc[4 * rq + 1], dd.y, bfhi(uu.x)), y2 = gelu_du(acc[4 * rq + 2], dd.z, bflo(uu.y)), y3 = gelu_du(acc[4 * rq + 3], dd.w, bfhi(uu.y));
        v2u o; o.x = cvt_pk_bf16(y0, y1); o.y = cvt_pk_bf16(y2, y3); *(GAS v2u*)(YG + off) = o; }
}
DI void s5_chain(Frame& F, int g, int b, int sub) {
    const int lane = F.lane, w = F.wave, r = lane & 31, h = lane >> 5;
    const bf16* U = (const bf16*)(F.ws + WS_U); const bf16* KC = (const bf16*)(F.ws + WS_KC); const bf16* VO = (const bf16*)(F.ws + WS_VOUT);
    const bf16* WE = (const bf16*)(F.ws + WS_WEND); const bf16* W4 = (const bf16*)(F.ws + WS_WEND4);
    LAS float* HEND = (LAS float*)(F.lds + S5_HEND); LAS unsigned char* HC = F.lds + S5_HC; LAS float* E = (LAS float*)(F.lds + S5_E);
    {
        const int mt = w & 3, half = w >> 2;
        bf16x8 wa[16];
#pragma unroll
        for (int ks = 0; ks < 16; ++ks) wa[ks] = ldg8(WE + ((size_t)g * 128 + 32 * mt + r) * 256 + 16 * ks + 8 * h);
#pragma unroll 1
        for (int cti = 0; cti < 2; ++cti) { const int chunk = 32 * (2 * half + cti) + r; const bf16* up = U + ((size_t)b * SEQ + chunk * 16) * S5W + g * SC + 8 * h;
            f32x16 acc = zero16();
#pragma unroll
            for (int ks = 0; ks < 16; ++ks) acc = MFMA32(wa[ks], ldg8(up + (size_t)ks * S5W), acc);
#pragma unroll
            for (int rq = 0; rq < 4; ++rq) *(LAS f32x4*)(HEND + chunk * 132 + 32 * mt + 8 * rq + 4 * h) = (f32x4){acc[4 * rq], acc[4 * rq + 1], acc[4 * rq + 2], acc[4 * rq + 3]};
        }
    }
    __syncthreads();
    {
        const int n = lane, seg = w; const float are = F.in[11][g * SN + n], aim = F.in[12][g * SN + n], dt = expf(F.in[13][g]);
        float s16, c16, s256, c256; sincosf(16.0f * dt * aim, &s16, &c16); sincosf(256.0f * dt * aim, &s256, &c256);
        const float m16 = expf(16.0f * dt * are), m256 = expf(256.0f * dt * are);
        const float ar = m16 * c16, ai = m16 * s16, Ar = m256 * c256, Ai = m256 * s256;
        float lr[16], li[16]; float xr = 0.f, xi = 0.f;
#pragma unroll
        for (int j = 0; j < 16; ++j) { lr[j] = xr; li[j] = xi; const float er = HEND[(16 * seg + j) * 132 + n], ei = HEND[(16 * seg + j) * 132 + 64 + n];
            const float nr = ar * xr - ai * xi + er, ni = ar * xi + ai * xr + ei; xr = nr; xi = ni; }
        E[(seg * 64 + n) * 2] = xr; E[(seg * 64 + n) * 2 + 1] = xi;
        __syncthreads();
        float Sr = 0.f, Si = 0.f;
        for (int s2 = 0; s2 < seg; ++s2) { const float er = E[(s2 * 64 + n) * 2], ei = E[(s2 * 64 + n) * 2 + 1]; const float nr = Ar * Sr - Ai * Si + er, ni = Ar * Si + Ai * Sr + ei; Sr = nr; Si = ni; }
        float pr = 1.f, pi = 0.f;
#pragma unroll
        for (int j = 0; j < 16; ++j) { const float hr = lr[j] + pr * Sr - pi * Si, hi = li[j] + pr * Si + pi * Sr;
            *(LAS bf16*)(HC + (16 * seg + j) * 272 + n * 2) = (bf16)f2bf(hr); *(LAS bf16*)(HC + (16 * seg + j) * 272 + (64 + n) * 2) = (bf16)f2bf(hi);
            const float qr = pr * ar - pi * ai, qi = pr * ai + pi * ar; pr = qr; pi = qi; }
        if (seg == 7) { F.out[O_S5RP + ((size_t)b * SG + g) * SN + n] = xr + pr * Sr - pi * Si; F.out[O_S5IP + ((size_t)b * SG + g) * SN + n] = xi + pr * Si + pi * Sr; }
    }
    __syncthreads();
    {
        const int tl = r >> 4, co = r & 15, t = 2 * w + tl;
        bf16x8 ka[16], va[8];
#pragma unroll
        for (int ks = 0; ks < 16; ++ks) { const int lag = t - ks; ka[ks] = lag >= 0 ? ldg8(KC + (((size_t)g * 16 + lag) * 16 + co) * 16 + 8 * h) : zero8(); }
#pragma unroll
        for (int kc = 0; kc < 8; ++kc) va[kc] = ldg8(VO + (((size_t)g * 16 + t) * 16 + co) * 128 + 16 * kc + 8 * h);
#pragma unroll 1
        for (int ct = 0; ct < 4; ++ct) { const int chunk = 32 * ct + r, tok0 = b * SEQ + chunk * 16; const bf16* up = U + (size_t)tok0 * S5W + g * SC + 8 * h;
            f32x16 acc = zero16();
#pragma unroll
            for (int ks = 0; ks < 16; ++ks) if (ks <= 2 * w + 1) acc = MFMA32(ka[ks], ldg8(up + (size_t)ks * S5W), acc);
#pragma unroll
            for (int kc = 0; kc < 8; ++kc) acc = MFMA32(va[kc], *(const LAS bf16x8*)(HC + chunk * 272 + (16 * kc + 8 * h) * 2), acc);
            s5_y_store(F, acc, g, tok0, 2 * w, h);
        }
        if (sub >= 0) { const int bs = 32 * sub + r, tok0 = MP + 4 * bs; const bf16* up = U + (size_t)tok0 * S5W + g * SC + 8 * h;
            const float* h0r = F.in[2] + ((size_t)bs * SG + g) * SN; const float* h0i = F.in[3] + ((size_t)bs * SG + g) * SN;
            if (w < 2) { f32x16 acc = zero16();
#pragma unroll
                for (int ks = 0; ks < 4; ++ks) if (ks <= 2 * w + 1) acc = MFMA32(ka[ks], ldg8(up + (size_t)ks * S5W), acc);
#pragma unroll
                for (int kc = 0; kc < 8; ++kc) { const float* src = (kc < 4 ? h0r : h0i) + 16 * (kc & 3) + 8 * h; const f32x4 x0 = *(const GAS f32x4*)src, x1 = *(const GAS f32x4*)(src + 4);
                    acc = MFMA32(va[kc], pack8(x0.x, x0.y, x0.z, x0.w, x1.x, x1.y, x1.z, x1.w), acc); }
                s5_y_store(F, acc, g, tok0, 2 * w, h); }
            if (w >= 4) { const int mt = w - 4; f32x16 acc = zero16();
#pragma unroll
                for (int ks = 0; ks < 4; ++ks) acc = MFMA32(ldg8(W4 + ((size_t)g * 128 + 32 * mt + r) * 64 + 16 * ks + 8 * h), ldg8(up + (size_t)ks * S5W), acc);
                const float* A4 = (const float*)(F.ws + WS_APOW) + 2 * (size_t)g * SN;
#pragma unroll
                for (int rq = 0; rq < 4; ++rq) { const int n0 = 32 * (mt & 1) + 8 * rq + 4 * h; const f32x4 hr = *(const GAS f32x4*)(h0r + n0), hi = *(const GAS f32x4*)(h0i + n0); f32x4 o;
#pragma unroll
                    for (int e = 0; e < 4; ++e) { const float a4r = A4[2 * (n0 + e)], a4i = A4[2 * (n0 + e) + 1];
                        o[e] = acc[4 * rq + e] + (mt < 2 ? (a4r * hr[e] - a4i * hi[e]) : (a4r * hi[e] + a4i * hr[e])); }
                    *(GAS f32x4*)(F.out + (mt < 2 ? O_S5RS : O_S5IS) + ((size_t)bs * SG + g) * SN + n0) = o; }
            }
        }
    }
    __syncthreads();
}
constexpr int HG_QT = 0, HG_KT = 8704, HG_VT = 17408, HG_DL = 26112, HG_TOT = 26624, HG_OT = 28672;
typedef short v4i16_t __attribute__((ext_vector_type(4)));
DI s16x4 tr16(LAS unsigned char* p) { return __builtin_bit_cast(s16x4, __builtin_amdgcn_ds_read_tr16_b64_v4i16((LAS v4i16_t*)p)); }
DI bf16x8 cat8(s16x4 a, s16x4 b) { return __builtin_shufflevector(a, b, 0, 1, 2, 3, 4, 5, 6, 7); }
DI void hg_prompt(Frame& F, int b, int hd) {
    const int tid = F.tid, lane = F.lane, w = F.wave, c16 = lane & 15, qd = lane >> 4;
    const bf16* Q = (const bf16*)(F.ws + WS_S0); const _Float16* LF = (const _Float16*)(F.ws + WS_S1); const bf16* V = (const bf16*)(F.ws + WS_S2); const bf16* Gt = (const bf16*)(F.ws + WS_S3);
    bf16* YH = (bf16*)(F.ws + WS_YH);
    LAS unsigned char* QT = F.lds + HG_QT; LAS unsigned char* KT = F.lds + HG_KT; LAS unsigned char* VT = F.lds + HG_VT;
    LAS float* DL = (LAS float*)(F.lds + HG_DL); LAS float* TOT = (LAS float*)(F.lds + HG_TOT); LAS float* OT = (LAS float*)(F.lds + HG_OT);
    const int ch = tid & 127, tq = tid >> 7;
    const int vt = tid >> 4, vp = tid & 15;
    f32x4 S[8];
#pragma unroll
    for (int m = 0; m < 8; ++m) S[m] = (f32x4){0.f, 0.f, 0.f, 0.f};
    const size_t colb = (size_t)hd * DK;
    _Float16 lfr[8]; bf16 qr[8]; v4u vv;
    {   const size_t row0 = (size_t)b * SEQ + 8 * tq;
#pragma unroll
        for (int i = 0; i < 8; ++i) { lfr[i] = LF[(row0 + i) * D + colb + ch]; qr[i] = Q[(row0 + i) * D + colb + ch]; }
        vv = *(const GAS v4u*)(V + ((size_t)b * SEQ + vt) * D + colb + 8 * vp); }
    const f32x4 gn0 = *(const GAS f32x4*)(F.in[22] + 8 * vp), gn1 = *(const GAS f32x4*)(F.in[22] + 8 * vp + 4);
#pragma unroll 1
    for (int c = 0; c < SEQ / 32; ++c) {
        const size_t tb = (size_t)b * SEQ + 32 * c;
        float cs[8]; float run = 0.f;
#pragma unroll
        for (int i = 0; i < 8; ++i) { run += (float)lfr[i]; cs[i] = run; }
        TOT[tq * 128 + ch] = run;
        *(LAS v4u*)(VT + vt * 272 + vp * 16) = vv;
        __syncthreads();
        float pre = 0.f, tot = 0.f;
#pragma unroll
        for (int q2 = 0; q2 < 4; ++q2) { const float x = TOT[q2 * 128 + ch]; tot += x; if (q2 < tq) pre += x; }
#pragma unroll
        for (int i = 0; i < 8; ++i) { const float bb = pre + cs[i], eb = __expf(bb), f = __expf((float)lfr[i]); const int t = 8 * tq + i;
            *(LAS bf16*)(QT + t * 272 + ch * 2) = (bf16)f2bf(bf2f(qr[i]) * eb); *(LAS bf16*)(KT + t * 272 + ch * 2) = (bf16)f2bf((1.0f - f) * frcp(eb)); }
        if (tq == 0) DL[ch] = __expf(tot);
        const v4u gg = *(const GAS v4u*)(Gt + (tb + vt) * D + colb + 8 * vp);
        if (c + 1 < SEQ / 32) {
            const size_t row0 = tb + 32 + 8 * tq;
#pragma unroll
            for (int i = 0; i < 8; ++i) { lfr[i] = LF[(row0 + i) * D + colb + ch]; qr[i] = Q[(row0 + i) * D + colb + ch]; }
            vv = *(const GAS v4u*)(V + (tb + 32 + vt) * D + colb + 8 * vp); }
        __syncthreads();
        f32x4 o0 = {0.f, 0.f, 0.f, 0.f}, o1 = o0;
        {   f32x4 p00 = o0, p01 = o0, p11 = o0;
#pragma unroll
            for (int ks = 0; ks < 4; ++ks) { const int kb = (32 * ks + 8 * qd) * 2;
                const bf16x8 ka0 = *(const LAS bf16x8*)(KT + c16 * 272 + kb), ka1 = *(const LAS bf16x8*)(KT + (16 + c16) * 272 + kb);
                const bf16x8 qb0 = *(const LAS bf16x8*)(QT + c16 * 272 + kb), qb1 = *(const LAS bf16x8*)(QT + (16 + c16) * 272 + kb);
                p00 = MFMA16(ka0, qb0, p00); p01 = MFMA16(ka0, qb1, p01); p11 = MFMA16(ka1, qb1, p11); }
#pragma unroll
            for (int i = 0; i < 4; ++i) { if (4 * qd + i > c16) { p00[i] = 0.f; p11[i] = 0.f; } }
#pragma unroll
            for (int ks = 0; ks < 4; ++ks) { const int kb = (32 * ks + 4 * qd) * 2;
                const s16x4 a0 = *(const LAS s16x4*)(QT + c16 * 272 + kb), a1 = *(const LAS s16x4*)(QT + c16 * 272 + kb + 32);
                const s16x4 b0 = *(const LAS s16x4*)(QT + (16 + c16) * 272 + kb), b1 = *(const LAS s16x4*)(QT + (16 + c16) * 272 + kb + 32);
                const bf16x8 sb = pack8(S[2 * ks][0], S[2 * ks][1], S[2 * ks][2], S[2 * ks][3], S[2 * ks + 1][0], S[2 * ks + 1][1], S[2 * ks + 1][2], S[2 * ks + 1][3]);
                o0 = MFMA16(cat8(a0, a1), sb, o0); o1 = MFMA16(cat8(b0, b1), sb, o1); }
            const int trb = (4 * qd + (c16 >> 2)) * 272 + (c16 & 3) * 8;
            const bf16x8 vb = cat8(tr16(VT + trb + 32 * w), tr16(VT + trb + 16 * 272 + 32 * w));
            o0 = MFMA16(pack8(p00[0], p00[1], p00[2], p00[3], 0.f, 0.f, 0.f, 0.f), vb, o0);
            o1 = MFMA16(pack8(p01[0], p01[1], p01[2], p01[3], p11[0], p11[1], p11[2], p11[3]), vb, o1);
#pragma unroll
            for (int m = 0; m < 8; ++m) { const bf16x8 kta = cat8(tr16(KT + trb + 32 * m), tr16(KT + trb + 16 * 272 + 32 * m));
                S[m] = MFMA16(kta, vb, S[m]); const f32x4 dl = *(const LAS f32x4*)(DL + 16 * m + 4 * qd); S[m] = S[m] * dl; }
        }
#pragma unroll
        for (int i = 0; i < 4; ++i) { OT[(4 * qd + i) * 132 + 16 * w + c16] = o0[i]; OT[(16 + 4 * qd + i) * 132 + 16 * w + c16] = o1[i]; }
        __syncthreads();
        {   const f32x4 x0 = *(const LAS f32x4*)(OT + vt * 132 + 8 * vp), x1 = *(const LAS f32x4*)(OT + vt * 132 + 8 * vp + 4);
            float ss = (x0.x * x0.x + x0.y * x0.y) + (x0.z * x0.z + x0.w * x0.w) + (x1.x * x1.x + x1.y * x1.y) + (x1.z * x1.z + x1.w * x1.w);
            ss += __shfl_xor(ss, 1); ss += __shfl_xor(ss, 2); ss += __shfl_xor(ss, 4); ss += __shfl_xor(ss, 8);
            const float rstd = 1.f / sqrtf(ss * (1.f / DV) + EPS);
            v4u o; o.x = cvt_pk_bf16(x0.x * rstd * gn0.x * bflo(gg.x), x0.y * rstd * gn0.y * bfhi(gg.x)); o.y = cvt_pk_bf16(x0.z * rstd * gn0.z * bflo(gg.y), x0.w * rstd * gn0.w * bfhi(gg.y));
            o.z = cvt_pk_bf16(x1.x * rstd * gn1.x * bflo(gg.z), x1.y * rstd * gn1.y * bfhi(gg.z)); o.w = cvt_pk_bf16(x1.z * rstd * gn1.z * bflo(gg.w), x1.w * rstd * gn1.w * bfhi(gg.w));
            *(GAS v4u*)(YH + (tb + vt) * D + colb + 8 * vp) = o; }
    }
    float* So = F.out + O_HGP + ((size_t)b * HH + hd) * DK * DV;
#pragma unroll
    for (int m = 0; m < 8; ++m)
#pragma unroll
        for (int i = 0; i < 4; ++i) So[(size_t)(16 * m + 4 * qd + i) * DV + 16 * w + c16] = S[m][i];
    __syncthreads();
}
constexpr int HS_QS = 0, HS_KS = 2048, HS_VS = 4096, HS_DL = 6144, HS_PS = 6656, HS_SS = 6784, HS_RED = 8192;
DI void hg_sample(Frame& F, int bs, int hd) {
    const int tid = F.tid, lane = F.lane, w = F.wave;
    const bf16* Q = (const bf16*)(F.ws + WS_S0); const _Float16* LF = (const _Float16*)(F.ws + WS_S1); const bf16* V = (const bf16*)(F.ws + WS_S2); const bf16* Gt = (const bf16*)(F.ws + WS_S3);
    bf16* YH = (bf16*)(F.ws + WS_YH);
    LAS float* QS = (LAS float*)(F.lds + HS_QS); LAS float* KS = (LAS float*)(F.lds + HS_KS); LAS float* VS = (LAS float*)(F.lds + HS_VS); LAS float* DLs = (LAS float*)(F.lds + HS_DL);
    LAS float* PS = (LAS float*)(F.lds + HS_PS); LAS float* SS = (LAS float*)(F.lds + HS_SS); LAS float* RED = (LAS float*)(F.lds + HS_RED);
    const size_t R0 = (size_t)MP + 4 * bs, colb = (size_t)hd * DK;
    const int dv4 = tid & 31, kg = tid >> 5;
    const float* S0 = F.in[4] + ((size_t)bs * HH + hd) * DK * DV; float* So = F.out + O_HGS + ((size_t)bs * HH + hd) * DK * DV;
    f32x4 s[8];
#pragma unroll
    for (int i = 0; i < 8; ++i) s[i] = *(const GAS f32x4*)(S0 + (size_t)(kg + 16 * i) * DV + 4 * dv4);
    if (tid < 128) { const int ch = tid; float run = 0.f;
#pragma unroll
        for (int t = 0; t < 4; ++t) { const float lf = (float)LF[(R0 + t) * D + colb + ch], q = bf2f(Q[(R0 + t) * D + colb + ch]); run += lf; const float eb = __expf(run);
            QS[t * 128 + ch] = q * eb; KS[t * 128 + ch] = (1.0f - __expf(lf)) * frcp(eb); }
        DLs[ch] = __expf(run);
    } else if (tid < 256) { const int ch = tid - 128;
#pragma unroll
        for (int t = 0; t < 4; ++t) VS[t * 128 + ch] = bf2f(V[(R0 + t) * D + colb + ch]); }
    __syncthreads();
#pragma unroll
    for (int pi = 0; pi < 2; ++pi) { const int p = w + 8 * pi; if (p < 10) { int t = 0, s2 = p; while (s2 > t) { s2 -= t + 1; ++t; }
            const float v = wave_sum(QS[t * 128 + lane] * KS[s2 * 128 + lane] + QS[t * 128 + 64 + lane] * KS[s2 * 128 + 64 + lane]); if (lane == 0) PS[t * 4 + s2] = v; } }
    f32x4 acc[4];
#pragma unroll
    for (int t = 0; t < 4; ++t) acc[t] = (f32x4){0.f, 0.f, 0.f, 0.f};
    f32x4 vs[4];
#pragma unroll
    for (int t = 0; t < 4; ++t) vs[t] = *(const LAS f32x4*)(VS + t * 128 + 4 * dv4);
#pragma unroll
    for (int i = 0; i < 8; ++i) { const int k = kg + 16 * i; f32x4 x = s[i];
#pragma unroll
        for (int t = 0; t < 4; ++t) { acc[t] = acc[t] + x * QS[t * 128 + k]; }
#pragma unroll
        for (int t = 0; t < 4; ++t) x = x + vs[t] * KS[t * 128 + k];
        *(GAS f32x4*)(So + (size_t)k * DV + 4 * dv4) = x * DLs[k]; }
#pragma unroll
    for (int t = 0; t < 4; ++t) *(LAS f32x4*)(RED + (kg * 4 + t) * 128 + 4 * dv4) = acc[t];
    __syncthreads();
    {   const int t = tid >> 7, dv = tid & 127; float o = 0.f;
#pragma unroll
        for (int k2 = 0; k2 < 16; ++k2) o += RED[(k2 * 4 + t) * 128 + dv];
        for (int s2 = 0; s2 <= t; ++s2) o += PS[t * 4 + s2] * VS[s2 * 128 + dv];
        const float ss = wave_sum(o * o); if (lane == 0) SS[w] = ss;
        __syncthreads();
        const float rstd = 1.f / sqrtf((SS[2 * t] + SS[2 * t + 1]) * (1.f / DV) + EPS);
        YH[(R0 + t) * D + colb + dv] = (bf16)f2bf(o * rstd * F.in[22][dv] * bf2f(Gt[(R0 + t) * D + colb + dv])); }
    __syncthreads();
}
DI void norm1_row(const Frame& F, int m) {
    const GAS f32x4* rr = (const GAS f32x4*)((const float*)(F.ws + WS_RAW1) + (size_t)m * D) + F.lane; const GAS f32x4* xr = (const GAS f32x4*)xrow(F, m) + F.lane;
    const GAS f32x4* g1 = (const GAS f32x4*)F.in[6] + F.lane; const GAS f32x4* g2 = (const GAS f32x4*)F.in[7] + F.lane;
    f32x4 v[4]; float s = 0.f;
#pragma unroll
    for (int j = 0; j < 4; ++j) { v[j] = rr[64 * j]; s += (v[j].x * v[j].x + v[j].y * v[j].y) + (v[j].z * v[j].z + v[j].w * v[j].w); }
    const float rstd = 1.f / sqrtf(wave_sum(s) * (1.f / D) + EPS); float s2 = 0.f;
    GAS f32x4* o = (GAS f32x4*)(F.out + O_Y + (size_t)m * D) + F.lane;
#pragma unroll
    for (int j = 0; j < 4; ++j) { v[j] = xr[64 * j] + v[j] * rstd * g1[64 * j]; o[64 * j] = v[j]; s2 += (v[j].x * v[j].x + v[j].y * v[j].y) + (v[j].z * v[j].z + v[j].w * v[j].w); }
    const float rstd2 = 1.f / sqrtf(wave_sum(s2) * (1.f / D) + EPS);
    GAS unsigned long long* o8 = (GAS unsigned long long*)((bf16*)(F.ws + WS_S3) + (size_t)m * D) + F.lane;
#pragma unroll
    for (int j = 0; j < 4; ++j) { const f32x4 gg = g2[64 * j];
        o8[64 * j] = (unsigned long long)pk2(v[j].x * rstd2 * gg.x, v[j].y * rstd2 * gg.y) | ((unsigned long long)pk2(v[j].z * rstd2 * gg.z, v[j].w * rstd2 * gg.w) << 32); }
}
DI void norm2_row(const Frame& F, int m) {
    const GAS f32x4* rr = (const GAS f32x4*)((const float*)(F.ws + WS_RAW2) + (size_t)m * D) + F.lane; const GAS f32x4* g1 = (const GAS f32x4*)F.in[8] + F.lane;
    GAS f32x4* o = (GAS f32x4*)(F.out + O_Y + (size_t)m * D) + F.lane;
    f32x4 v[4]; float s = 0.f;
#pragma unroll
    for (int j = 0; j < 4; ++j) { v[j] = rr[64 * j]; s += (v[j].x * v[j].x + v[j].y * v[j].y) + (v[j].z * v[j].z + v[j].w * v[j].w); }
    const float rstd = 1.f / sqrtf(wave_sum(s) * (1.f / D) + EPS);
#pragma unroll
    for (int j = 0; j < 4; ++j) o[64 * j] = o[64 * j] + v[j] * rstd * g1[64 * j];
}

struct Args { const float* in[28]; float* out; unsigned char* ws; int ph_lo, ph_hi, li, pad; };
__global__ void __launch_bounds__(NWAVES * 64, 2) mk_fwd(Args args) {
    extern __shared__ __attribute__((aligned(16))) unsigned char lds[];
    Frame F;
    F.lds = (LAS unsigned char*)lds; F.MISC = (volatile LAS unsigned*)(F.lds + MISC_OFF);
    F.tid = threadIdx.x; F.lane = F.tid & 63; F.wave = __builtin_amdgcn_readfirstlane(F.tid >> 6);
    F.G = gridDim.x; { const int bx = blockIdx.x; F.vcu = (F.G % 8 == 0) ? (bx % 8) * (F.G / 8) + bx / 8 : bx; }
#pragma unroll
    for (int i = 0; i < 28; ++i) F.in[i] = args.in[i];
    F.out = args.out; F.ws = args.ws; F.ctl = (gu32*)(args.ws + WS_CTL);
    for (int u = F.tid; u < (LDS_BYTES - LDSCTL_OFF) / 4; u += NWAVES * 64) ((LAS unsigned*)(F.lds + LDSCTL_OFF))[u] = 0u;
    __syncthreads();
    XcdBarrier bar; bar.bar = (unsigned*)(F.ctl + CW_BAR); bar.x = 0; bar.st = nullptr;
    if (N_LAUNCHES == 1) bar = xcd_barrier_post((unsigned*)(F.ctl + CW_BAR), F.MISC + 8);
#define GRID_BAR() do { if (N_LAUNCHES == 1) xcd_barrier(bar); } while (0)
    const int lo = args.ph_lo, hi = args.ph_hi;
#define IN(k) (lo <= (k) && (k) < hi)
#define BOTH(k) (IN(k) && IN((k) + 1))
    const int gw = F.vcu * NWAVES + F.wave, NGW = F.G * NWAVES;
    const int bx = (int)blockIdx.x;
    if (IN(0)) { p0_prologue(F); if (BOTH(0)) GRID_BAR(); }
    if (IN(1)) {
        pg8::Gemm g{(const bf16*)(F.ws + WS_XN), (const bf16*)(F.ws + WS_WIN), M, NIN, D}; pg8::StaticOrder S; S.init(M, NIN, F.G, bx);
        pg8::EpiIn E{(bf16*)(F.ws + WS_U), (bf16*)(F.ws + WS_S0), (bf16*)(F.ws + WS_S1), (bf16*)(F.ws + WS_S2), (bf16*)(F.ws + WS_S3), (bf16*)F.out, (bf16*)F.out + (size_t)M * D, F.in[10], F.in[21]};
        pg8::gemm_phase<pg8::EpiIn, pg8::StaticOrder, true, true>(F.lds, g, S, E);
        if (BOTH(1)) GRID_BAR();
    }
    if (IN(2)) {
        { const int g = bx >> 3, b = bx & 7; if (bx < SG * NB) s5_chain(F, g, b, b < 4 ? b : -1); }
        if (bx < NB * HH) hg_prompt(F, bx >> 3, bx & 7);
        else for (int it = bx - NB * HH; it < DB * HH; it += F.G - NB * HH) hg_sample(F, it >> 3, it & 7);
        if (BOTH(2)) GRID_BAR();
    }
    if (IN(3)) {
        pg8::Gemm g{(const bf16*)(F.ws + WS_YG), (const bf16*)(F.ws + WS_WGLU), M, S5W, S5W}; pg8::StaticOrder S; S.init(M, S5W, F.G, bx);
        pg8::EpiElem<0> E{(bf16*)(F.ws + WS_YS5), (const bf16*)(F.ws + WS_YG), S5W, F.in[20]};
        pg8::gemm_phase<pg8::EpiElem<0>, pg8::StaticOrder, true, true>(F.lds, g, S, E);
        if (BOTH(3)) GRID_BAR();
    }
    if (IN(4)) {
        { pg8::Gemm g{(const bf16*)(F.ws + WS_YS5), (const bf16*)(F.ws + WS_WBRS), M, D, S5W}; pg8::StaticOrder S; S.init(M, D, F.G, bx);
          pg8::EpiElem<1> E{(bf16*)(F.ws + WS_S2), (const bf16*)F.out, D, nullptr};
          pg8::gemm_phase<pg8::EpiElem<1>, pg8::StaticOrder, true, true>(F.lds, g, S, E); }
        VM_WAIT(); __syncthreads(); __builtin_amdgcn_fence(__ATOMIC_ACQUIRE, "agent"); VM_WAIT(); __syncthreads();
        { pg8::Gemm g{(const bf16*)(F.ws + WS_YH), (const bf16*)(F.ws + WS_WBRH), M, D, D}; pg8::StaticOrder S; S.init(M, D, F.G, bx);
          pg8::EpiElem<2> E{(bf16*)(F.ws + WS_S2), (const bf16*)F.out + (size_t)M * D, D, nullptr};
          pg8::gemm_phase<pg8::EpiElem<2>, pg8::StaticOrder, true, true>(F.lds, g, S, E); }
        if (BOTH(4)) GRID_BAR();
    }
    if (IN(5)) {
        pg8::Gemm g{(const bf16*)(F.ws + WS_S2), (const bf16*)(F.ws + WS_WOUT), M, D, D}; pg8::StaticOrder S; S.init(M, D, F.G, bx);
        pg8::EpiRaw E{(float*)(F.ws + WS_RAW1), D};
        pg8::gemm_phase<pg8::EpiRaw, pg8::StaticOrder, true, true>(F.lds, g, S, E);
        if (BOTH(5)) GRID_BAR();
    }
    if (IN(6)) { for (int m = gw; m < M; m += NGW) norm1_row(F, m); if (BOTH(6)) GRID_BAR(); }
    if (IN(7)) {
        pg8::Gemm g{(const bf16*)(F.ws + WS_S3), (const bf16*)(F.ws + WS_WUP), M, FF, D}; pg8::StaticOrder S; S.init(M, FF, F.G, bx);
        pg8::EpiElem<3> E{(bf16*)(F.ws + WS_HMID), nullptr, FF, nullptr};
        pg8::gemm_phase<pg8::EpiElem<3>, pg8::StaticOrder, true, true>(F.lds, g, S, E);
        if (BOTH(7)) GRID_BAR();
    }
    if (IN(8)) {
        pg8::Gemm g{(const bf16*)(F.ws + WS_HMID), (const bf16*)(F.ws + WS_WDN), M, D, FF}; pg8::StaticOrder S; S.init(M, D, F.G, bx);
        pg8::EpiRaw E{(float*)(F.ws + WS_RAW2), D};
        pg8::gemm_phase<pg8::EpiRaw, pg8::StaticOrder, true, true>(F.lds, g, S, E);
        if (BOTH(8)) GRID_BAR();
    }
    if (IN(9)) { for (int m = gw; m < M; m += NGW) norm2_row(F, m); }
#undef IN
#undef BOTH
}

#if defined(MK_DEBUG) && MK_DEBUG
constexpr int CW_DBG = 8;
DI bool dclose(float got, float ex, float tol) { return fabsf(got - ex) <= tol + tol * fabsf(ex); }
DI void dflag(unsigned char* ws, int bit) { atomicOr((unsigned*)(ws + WS_CTL) + CW_DBG, 1u << bit); }
DI float ddot(const bf16* a, const bf16* b, int K) { float s = 0.f; for (int k = 0; k < K; ++k) s += bf2f(a[k]) * bf2f(b[k]); return s; }
__global__ void __launch_bounds__(512) dbg_check(Args args, int which) {
    __shared__ float red[8 * 128 + 64];
    unsigned char* ws = args.ws; const int tid = threadIdx.x, lane = tid & 63, w = tid >> 6, bx = blockIdx.x;
    const unsigned idx = bx * 512 + tid; const unsigned hsh = idx * 2654435761u;
    const bf16* U = (const bf16*)(ws + WS_U); const bf16* Q = (const bf16*)(ws + WS_S0); const _Float16* LF = (const _Float16*)(ws + WS_S1); const bf16* V = (const bf16*)(ws + WS_S2); const bf16* Gt = (const bf16*)(ws + WS_S3);
    const bf16* GS5 = (const bf16*)args.out; const bf16* GHG = (const bf16*)args.out + (size_t)M * D; const bf16* YG = (const bf16*)(ws + WS_YG); const bf16* YS5 = (const bf16*)(ws + WS_YS5); const bf16* YH = (const bf16*)(ws + WS_YH);
    const bf16* MG = (const bf16*)(ws + WS_S2);
    if (which == 1) {
        const int row = hsh % M, col = (hsh >> 7) % NIN;
        float v = ddot((const bf16*)(ws + WS_XN) + (size_t)row * D, (const bf16*)(ws + WS_WIN) + (size_t)col * D, D) + args.in[10][col];
        float got; bool ok;
        if (col < 512) { got = bf2f(U[(size_t)row * 512 + col]); ok = dclose(got, v, 0.02f); }
        else { const int s = (col - 512) >> 10, c = (col - 512) & 1023; const size_t o = (size_t)row * D + c;
            if (s == 0) { got = bf2f(Q[o]); ok = dclose(got, v / (1.f + expf(-v)), 0.02f); }
            else if (s == 1) { const float l0 = args.in[21][c], l1 = args.in[21][1024 + c], lb = expf(l0) / (expf(l0) + expf(l1)); got = (float)LF[o]; ok = dclose(got, logf(lb + (1.f - lb) / (1.f + expf(-v))), 0.01f); }
            else if (s == 2) { got = bf2f(V[o]); ok = dclose(got, v, 0.02f); }
            else if (s == 3) { got = bf2f(Gt[o]); ok = dclose(got, v / (1.f + expf(-v)), 0.02f); }
            else if (s == 4) { got = bf2f(GS5[o]); ok = dclose(got, 1.f / (1.f + expf(-v)), 0.02f); }
            else { got = bf2f(GHG[o]); ok = dclose(got, 1.f / (1.f + expf(-v)), 0.02f); } }
        if (!ok) { int sg = col < 512 ? 0 : 1 + ((col - 512) >> 10); dflag(ws, sg); atomicAdd((unsigned*)(ws + WS_CTL) + 9, 1u); }
    }
    if (which == 2) {
        if (bx < 64) {
            if (w == 0) { const bool smp = bx >= 32; const int g = smp ? bx - 32 : bx, b = bx & 7, bs = 4 * (bx - 32) + 1, n = lane;
                const float are = args.in[11][g * SN + n], aim = args.in[12][g * SN + n], dt = expf(args.in[13][g]);
                const float mag = expf(dt * are), abr = mag * cosf(dt * aim), abi = mag * sinf(dt * aim), den = are * are + aim * aim, nr = abr - 1.f, ni = abi;
                const float cr = (nr * are + ni * aim) / den, ci = (ni * are - nr * aim) / den;
                float hr = smp ? args.in[2][((size_t)bs * SG + g) * SN + n] : 0.f, hi = smp ? args.in[3][((size_t)bs * SG + g) * SN + n] : 0.f;
                const int L = smp ? 4 : SEQ; const size_t tok0 = smp ? (size_t)MP + 4 * bs : (size_t)b * SEQ; int bad = 0;
                for (int t = 0; t < L; ++t) { float bur = 0.f, bui = 0.f;
                    for (int c = 0; c < 16; ++c) { const float u = bf2f(U[(tok0 + t) * 512 + g * 16 + c]); const float br = args.in[14][((size_t)g * SN + n) * 16 + c], bi = args.in[15][((size_t)g * SN + n) * 16 + c];
                        bur += (cr * br - ci * bi) * u; bui += (cr * bi + ci * br) * u; }
                    const float nhr = abr * hr - abi * hi + bur, nhi = abr * hi + abi * hr + bui; hr = nhr; hi = nhi;
                    for (int c = 0; c < 16; ++c) { float y = args.in[16][((size_t)g * 16 + c) * SN + n] * hr - args.in[17][((size_t)g * 16 + c) * SN + n] * hi; y = wave_sum(y);
                        const float u = bf2f(U[(tok0 + t) * 512 + g * 16 + c]); y += args.in[18][g * 16 + c] * u; y = 0.5f * y * (1.f + tanhf(0.7978845608f * (y + 0.044715f * y * y * y)));
                        if (!dclose(bf2f(YG[(tok0 + t) * 512 + g * 16 + c]), y, 0.04f)) bad = 1; } }
                if (bad) dflag(ws, smp ? 4 : 2);
                const float gr = smp ? args.out[O_S5RS + ((size_t)bs * SG + g) * SN + n] : args.out[O_S5RP + ((size_t)b * SG + g) * SN + n];
                const float gi = smp ? args.out[O_S5IS + ((size_t)bs * SG + g) * SN + n] : args.out[O_S5IP + ((size_t)b * SG + g) * SN + n];
                if (!dclose(gr, hr, 0.03f) || !dclose(gi, hi, 0.03f)) dflag(ws, smp ? 4 : 3); }
        } else if (bx < 192) {
            const bool smp = bx >= 128; const int j = bx - 64, b = j >> 3, hd = bx & 7, bs = 2 * (bx - 128) + 1;
            const int k = tid >> 2, q4 = tid & 3; float S[32];
            const float* S0 = args.in[4] + ((size_t)bs * HH + hd) * DK * DV;
            for (int e = 0; e < 32; ++e) S[e] = smp ? S0[(size_t)k * DV + 32 * q4 + e] : 0.f;
            const int L = smp ? 4 : SEQ; const size_t tok0 = smp ? (size_t)MP + 4 * bs : (size_t)b * SEQ; int bad = 0;
            for (int t = 0; t < L; ++t) { const size_t ro = (tok0 + t) * D + hd * 128;
                const float f = expf((float)LF[ro + k]), kk = 1.f - f, qv = bf2f(Q[ro + k]); float part[32];
                for (int e = 0; e < 32; ++e) { S[e] = f * S[e] + kk * bf2f(V[ro + 32 * q4 + e]); part[e] = qv * S[e]; }
                for (int e = 0; e < 32; ++e) { float p = part[e]; p += __shfl_xor(p, 4); p += __shfl_xor(p, 8); p += __shfl_xor(p, 16); p += __shfl_xor(p, 32); part[e] = p; }
                __syncthreads();
                if (lane < 4) for (int e = 0; e < 32; ++e) red[w * 128 + 32 * q4 + e] = part[e];
                __syncthreads();
                float o = 0.f; if (tid < 128) { for (int w2 = 0; w2 < 8; ++w2) o += red[w2 * 128 + tid]; }
                const float ss = wave_sum(o * o); if (tid < 128 && lane == 0) red[1024 + w] = ss;
                __syncthreads();
                if (tid < 128) { const float rstd = 1.f / sqrtf((red[1024] + red[1025]) / 128.f + EPS); const float ex = o * rstd * args.in[22][tid] * bf2f(Gt[ro + tid]);
                    if (!dclose(bf2f(YH[ro + tid]), ex, 0.05f)) bad = 1; } }
            if (bad) dflag(ws, smp ? 6 : 5);
            const float* So = args.out + (smp ? O_HGS + ((size_t)bs * HH + hd) * DK * DV : O_HGP + ((size_t)b * HH + hd) * DK * DV);
            for (int e = 0; e < 32; ++e) if (!dclose(So[(size_t)k * DV + 32 * q4 + e], S[e], 0.03f)) dflag(ws, smp ? 6 : 5);
        }
    }
    if (which == 3) { const int row = hsh % M, col = (hsh >> 9) % S5W; const float z = ddot(YG + (size_t)row * 512, (const bf16*)(ws + WS_WGLU) + (size_t)col * 512, 512) + args.in[20][col];
        if (!dclose(bf2f(YS5[(size_t)row * 512 + col]), bf2f(YG[(size_t)row * 512 + col]) / (1.f + expf(-z)), 0.02f)) dflag(ws, 7); }
    if (which == 4) { const int row = hsh % M, col = (hsh >> 9) % D; const size_t o = (size_t)row * D + col;
        const float a = ddot(YS5 + (size_t)row * 512, (const bf16*)(ws + WS_WBRS) + (size_t)col * 512, 512), c = ddot(YH + (size_t)row * D, (const bf16*)(ws + WS_WBRH) + (size_t)col * D, D);
        if (!dclose(bf2f(MG[o]), bf2f(GS5[o]) * a + bf2f(GHG[o]) * c, 0.03f)) dflag(ws, 8); }
    if (which == 5) { const int row = hsh % M, col = (hsh >> 9) % D;
        if (!dclose(((const float*)(ws + WS_RAW1))[(size_t)row * D + col], ddot(MG + (size_t)row * D, (const bf16*)(ws + WS_WOUT) + (size_t)col * D, D), 0.02f)) dflag(ws, 9); }
    if (which == 7) { const int row = hsh % M, col = (hsh >> 9) % FF; const float z = fmaxf(ddot((const bf16*)(ws + WS_S3) + (size_t)row * D, (const bf16*)(ws + WS_WUP) + (size_t)col * D, D), 0.f);
        if (!dclose(bf2f(((const bf16*)(ws + WS_HMID))[(size_t)row * FF + col]), z * z, 0.02f)) dflag(ws, 10); }
    if (which == 8) { const int row = hsh % M, col = (hsh >> 9) % D;
        if (!dclose(((const float*)(ws + WS_RAW2))[(size_t)row * D + col], ddot((const bf16*)(ws + WS_HMID) + (size_t)row * FF, (const bf16*)(ws + WS_WDN) + (size_t)col * FF, FF), 0.02f)) dflag(ws, 11); }
    if (which == 6 || which == 9) {
        const int row = (hsh >> 6) % M; const float* raw = (const float*)(ws + (which == 6 ? WS_RAW1 : WS_RAW2)) + (size_t)row * D; const float* x1 = args.out + (size_t)row * D;
        if (which == 6) { const float* xr = row < MP ? args.in[0] + (size_t)row * D : args.in[1] + (size_t)(row - MP) * D; float s = 0.f; for (int c = 0; c < D; ++c) s += raw[c] * raw[c];
            const float rstd = 1.f / sqrtf(s / D + EPS); float s2 = 0.f; int bad = 0;
            for (int c = 0; c < D; ++c) { const float e = xr[c] + raw[c] * rstd * args.in[6][c]; if (!dclose(x1[c], e, 0.001f)) bad = 1; s2 += e * e; }
            const float r2 = 1.f / sqrtf(s2 / D + EPS);
            for (int c = 0; c < D; ++c) if (!dclose(bf2f(((const bf16*)(ws + WS_S3))[(size_t)row * D + c]), x1[c] * r2 * args.in[7][c], 0.02f)) bad = 1;
            if (bad && (tid & 63) == 0) dflag(ws, 12); }
    }
}
__global__ void dbg_report(Args args) { const unsigned m = ((unsigned*)(args.ws + WS_CTL))[CW_DBG], cnt = ((unsigned*)(args.ws + WS_CTL))[9]; if (m) { const int b = __ffs(m) - 1; const float X = ldexpf(1.0f, 26 - b); args.out[0] = X; args.out[(size_t)MP * D] = X * (0.2f + 0.75f * (float)cnt / 131072.f); } }
#endif
extern "C" void kernel_launch(void* const* d_in, const int* in_sizes, int n_in, void* d_out, int out_size, void* d_ws, size_t ws_size, hipStream_t stream) {
    static int grid = 0;
    if (grid == 0) {
        if (n_in != 28 || in_sizes[0] != MP * D || in_sizes[1] != MS * D || (size_t)out_size != O_END || ws_size < WS_END) {
            fprintf(stderr, "kernel_launch: shape mismatch: n_in %d in0 %d in1 %d out %d ws %zu (need %zu); nothing launched\n", n_in, n_in > 0 ? in_sizes[0] : -1, n_in > 1 ? in_sizes[1] : -1, out_size, ws_size, (size_t)WS_END); grid = -1; return; }
        int dev = 0, cus = 0, per_cu = 0;
        if (hipGetDevice(&dev) != hipSuccess || hipDeviceGetAttribute(&cus, hipDeviceAttributeMultiprocessorCount, dev) != hipSuccess) { fprintf(stderr, "kernel_launch: device query failed\n"); grid = -1; return; }
        if (hipFuncSetAttribute((const void*)mk_fwd, hipFuncAttributeMaxDynamicSharedMemorySize, LDS_BYTES) != hipSuccess) { fprintf(stderr, "kernel_launch: hipFuncSetAttribute failed\n"); grid = -1; return; }
        if (hipOccupancyMaxActiveBlocksPerMultiprocessor(&per_cu, (const void*)mk_fwd, NWAVES * 64, LDS_BYTES) != hipSuccess || per_cu < 1) { fprintf(stderr, "kernel_launch: occupancy query says %d blocks per CU\n", per_cu); per_cu = per_cu < 1 ? 0 : per_cu; }
        (void)hipGetLastError();
        grid = cus;
        if (per_cu < 1 || grid != 256) { fprintf(stderr, "kernel_launch: need 256 CUs with one resident block each (cus %d, per_cu %d)\n", cus, per_cu); if (per_cu < 1) { grid = -1; return; } }
    }
    if (grid < 0) return;
    (void)hipMemsetAsync((char*)d_ws + WS_CTL, 0, CTL_ZERO_BYTES, stream);
    Args a{};
    for (int i = 0; i < 28; ++i) a.in[i] = (const float*)d_in[i];
    a.out = (float*)d_out; a.ws = (unsigned char*)d_ws;
    for (int li = 0; li < N_LAUNCHES; ++li) {
        a.ph_lo = (N_LAUNCHES == 1) ? 0 : li; a.ph_hi = (N_LAUNCHES == 1) ? N_PHASES : li + 1; a.li = li; a.pad = 0;
        hipLaunchKernelGGL(mk_fwd, dim3(grid), dim3(NWAVES * 64), LDS_BYTES, stream, a);
#if defined(MK_DEBUG) && MK_DEBUG
        if (N_LAUNCHES == N_PHASES && li >= 1 && li <= 8 && ((MK_DEBUG >> li) & 1)) hipLaunchKernelGGL(dbg_check, dim3(256), dim3(512), 0, stream, a, li);
#endif
    }
#if defined(MK_DEBUG) && MK_DEBUG
    hipLaunchKernelGGL(dbg_report, dim3(1), dim3(1), 0, stream, a);
#endif
}
```

```cpp
#include <hip/hip_runtime.h>
#include <cstdio>
#include <cstdint>
namespace pg8 {
#define PG8_LAS __attribute__((address_space(3)))
typedef unsigned short bf16_t;
typedef short bf16x8 __attribute__((ext_vector_type(8)));
typedef float f32x4 __attribute__((ext_vector_type(4)));
typedef unsigned u32x4 __attribute__((ext_vector_type(4)));
constexpr int BM = 256, BK = 64, HALF = 128, HTB = HALF * BK * 2  , STAGE_BYTES = 8 * HTB, NXCD = 8, WGM = 8;

__host__ __device__ __forceinline__ int lds_byte(int r, int c) { const int st = (r >> 4) * 2 + (c >> 5), rr = r & 15, cc = c & 31, ob = rr * 64 + cc * 2; return st * 1024 + (ob ^ (((ob >> 9) & 1) << 5)); }
__host__ __device__ __forceinline__ void stage_rc(int b, int& R, int& C) { const int st = b / 1024, sb = b % 1024, swz = sb ^ (((sb >> 9) & 1) << 5); R = (st >> 1) * 16 + swz / 64; C = (st & 1) * 32 + (swz % 64) / 2; }
__host__ __device__ __forceinline__ int perm32(int rho) { const int n = rho >> 4, i = rho & 15; return 8 * (i >> 2) + 4 * n + (i & 3); }

struct Unit { int pm, pn; };
struct Gemm { const bf16_t* A; const bf16_t* Bt; int M, N, K; };

struct StaticOrder {
    int nM, nN, nwg, G, c;
    __host__ __device__ void init(int M, int N, int G_, int c_) { nM = M / BM; nN = N / BM; nwg = nM * nN; G = G_; c = c_; }
    __host__ __device__ bool next(int i, Unit& u) const {
        const long L = (long)i * G + c; if (L >= nwg) return false;
        int wgid = (int)L; { const int q = nwg / NXCD, r = nwg % NXCD, xcd = wgid % NXCD, off = wgid / NXCD; wgid = (xcd < r ? xcd * (q + 1) : r * (q + 1) + (xcd - r) * q) + off; }
        const int nig = WGM * nN, gid = wgid / nig, fm = gid * WGM, gsz = (nM - fm) < WGM ? (nM - fm) : WGM;
        u.pm = fm + ((wgid % nig) % gsz); u.pn = (wgid % nig) / gsz; return true;
    }
    __device__ __forceinline__ void a_ready(const Unit&) const {}
    __device__ __forceinline__ void done(const Unit&) const {}
};

typedef float f32x2_t __attribute__((ext_vector_type(2))); typedef __bf16 bf16x2_t __attribute__((ext_vector_type(2)));
__device__ __forceinline__ unsigned cvt_pk_bf16(float lo, float hi) { const f32x2_t v = {lo, hi}; const bf16x2_t b = __builtin_convertvector(v, bf16x2_t); return __builtin_bit_cast(unsigned, b); }
typedef float f32x2 __attribute__((ext_vector_type(2)));
typedef unsigned u32x2 __attribute__((ext_vector_type(2)));
typedef _Float16 h16x2 __attribute__((ext_vector_type(2)));
__device__ __forceinline__ float bf2f(unsigned short b) { return __uint_as_float((unsigned)b << 16); }
__device__ __forceinline__ float bflo(unsigned w) { return __uint_as_float(w << 16); }
__device__ __forceinline__ float bfhi(unsigned w) { return __uint_as_float(w & 0xffff0000u); }
__device__ __forceinline__ float frcp(float x) { return __builtin_amdgcn_rcpf(x); }
__device__ __forceinline__ float sigm(float x) { return frcp(1.0f + __expf(-x)); }
__device__ __forceinline__ float siluf(float x) { return x * sigm(x); }
__device__ __forceinline__ float gelu_tanh(float x) { const float u = 0.7978845608028654f * (x + 0.044715f * x * x * x); return x * sigm(2.0f * u); }
__device__ __forceinline__ unsigned pk_f16(float lo, float hi) { h16x2 v = {(_Float16)lo, (_Float16)hi}; return __builtin_bit_cast(unsigned, v); }

struct EpiIn {
    static constexpr bool PERM = true, AFTER_DRAIN = false;
    bf16_t *U, *Q, *LF, *V, *G, *GS5, *GHG; const float* bias; const float* lbl; const float* gnorm;
    template <int TYPE> __device__ __forceinline__ void body(const f32x4 (&acc)[2][2][4][2], bf16_t* base, int ldc, int row0, int col0, int bcol0) const {
        f32x4 bv[2][2], lb[2][2];
#pragma unroll
        for (int bj = 0; bj < 2; ++bj)
#pragma unroll
            for (int n = 0; n < 2; ++n) { bv[bj][n] = *(const f32x4*)(bias + bcol0 + bj * HALF + 4 * n);
                if (TYPE == 4) lb[bj][n] = *(const f32x4*)(gnorm + ((col0 + bj * HALF + 4 * n) & 127));
                if (TYPE == 2) { const f32x4 l0 = *(const f32x4*)(lbl + col0 + bj * HALF + 4 * n), l1 = *(const f32x4*)(lbl + 1024 + col0 + bj * HALF + 4 * n);
#pragma unroll
                    for (int e = 0; e < 4; ++e) lb[bj][n][e] = frcp(1.0f + __expf(l1[e] - l0[e])); } }
#pragma unroll
        for (int ai = 0; ai < 2; ++ai)
#pragma unroll
            for (int m = 0; m < 4; ++m) { bf16_t* rowp = base + (size_t)(row0 + ai * HALF + m * 16) * ldc + col0;
#pragma unroll
                for (int bj = 0; bj < 2; ++bj) { float v[8];
#pragma unroll
                    for (int e = 0; e < 4; ++e) { v[e] = acc[ai][bj][m][0][e] + bv[bj][0][e]; v[4 + e] = acc[ai][bj][m][1][e] + bv[bj][1][e]; }
                    u32x4 w;
                    if (TYPE == 2) {
#pragma unroll
                        for (int e = 0; e < 8; ++e) { const float l = lb[bj][e >> 2][e & 3]; v[e] = l + (1.0f - l) * sigm(v[e]); }
                        w.x = pk_f16(v[0], v[1]); w.y = pk_f16(v[2], v[3]); w.z = pk_f16(v[4], v[5]); w.w = pk_f16(v[6], v[7]);
                    } else {
#pragma unroll
                        for (int e = 0; e < 8; ++e) { if (TYPE == 1) v[e] = siluf(v[e]); if (TYPE == 3) v[e] = sigm(v[e]); if (TYPE == 4) v[e] = siluf(v[e]) * lb[bj][e >> 2][e & 3]; }
                        w.x = cvt_pk_bf16(v[0], v[1]); w.y = cvt_pk_bf16(v[2], v[3]); w.z = cvt_pk_bf16(v[4], v[5]); w.w = cvt_pk_bf16(v[6], v[7]);
                    }
                    *(u32x4*)(rowp + bj * HALF) = w; } }
    }
    __device__ __forceinline__ void operator()(const f32x4 (&acc)[2][2][4][2], const Unit& u, int wr, int wc, int fr, int fq) const {
        const int row0 = u.pm * BM + wr * 64 + fr, bcol0 = u.pn * BM + wc * 32 + 8 * fq;
        if (u.pn < 2) { body<0>(acc, U, 512, row0, u.pn * BM + wc * 32 + 8 * fq, bcol0); return; }
        const int s = (u.pn - 2) >> 2, col0 = ((u.pn - 2) & 3) * BM + wc * 32 + 8 * fq;
        if (s == 0) body<1>(acc, Q, 1024, row0, col0, bcol0);
        else if (s == 1) body<2>(acc, LF, 1024, row0, col0, bcol0);
        else if (s == 2) body<0>(acc, V, 1024, row0, col0, bcol0);
        else if (s == 3) body<4>(acc, G, 1024, row0, col0, bcol0);
        else if (s == 4) body<3>(acc, GS5, 1024, row0, col0, bcol0);
        else body<3>(acc, GHG, 1024, row0, col0, bcol0);
    }
};
template <int MODE> struct EpiElem {
    static constexpr bool PERM = true, AFTER_DRAIN = false;
    bf16_t* O; const bf16_t* P; int ldc; const float* bias;
    __device__ __forceinline__ void operator()(const f32x4 (&acc)[2][2][4][2], const Unit& u, int wr, int wc, int fr, int fq) const {
        const int row0 = u.pm * BM + wr * 64 + fr, col0 = u.pn * BM + wc * 32 + 8 * fq;
        f32x4 bv[2][2];
        if (MODE == 0) {
#pragma unroll
            for (int bj = 0; bj < 2; ++bj)
#pragma unroll
                for (int n = 0; n < 2; ++n) bv[bj][n] = *(const f32x4*)(bias + col0 + bj * HALF + 4 * n); }
#pragma unroll
        for (int ai = 0; ai < 2; ++ai)
#pragma unroll
            for (int m = 0; m < 4; ++m) { const size_t off = (size_t)(row0 + ai * HALF + m * 16) * ldc + col0;
#pragma unroll
                for (int bj = 0; bj < 2; ++bj) { float v[8];
#pragma unroll
                    for (int e = 0; e < 4; ++e) { v[e] = acc[ai][bj][m][0][e]; v[4 + e] = acc[ai][bj][m][1][e]; }
                    if (MODE == 0) {
#pragma unroll
                        for (int e = 0; e < 8; ++e) v[e] = sigm(v[e] + bv[bj][e >> 2][e & 3]); }
                    if (MODE == 3) {
#pragma unroll
                        for (int e = 0; e < 8; ++e) { const float r = fmaxf(v[e], 0.0f); v[e] = r * r; } }
                    if (MODE <= 2) { const u32x4 p = *(const u32x4*)(P + off + bj * HALF);
                        v[0] *= bflo(p.x); v[1] *= bfhi(p.x); v[2] *= bflo(p.y); v[3] *= bfhi(p.y); v[4] *= bflo(p.z); v[5] *= bfhi(p.z); v[6] *= bflo(p.w); v[7] *= bfhi(p.w); }
                    if (MODE == 2) { const u32x4 o = *(const u32x4*)(O + off + bj * HALF);
                        v[0] += bflo(o.x); v[1] += bfhi(o.x); v[2] += bflo(o.y); v[3] += bfhi(o.y); v[4] += bflo(o.z); v[5] += bfhi(o.z); v[6] += bflo(o.w); v[7] += bfhi(o.w); }
                    u32x4 w; w.x = cvt_pk_bf16(v[0], v[1]); w.y = cvt_pk_bf16(v[2], v[3]); w.z = cvt_pk_bf16(v[4], v[5]); w.w = cvt_pk_bf16(v[6], v[7]);
                    *(u32x4*)(O + off + bj * HALF) = w; } }
    }
};
struct EpiRaw {
    static constexpr bool PERM = false, AFTER_DRAIN = false;
    float* O; int ldc;
    __device__ __forceinline__ void operator()(const f32x4 (&acc)[2][2][4][2], const Unit& u, int wr, int wc, int fr, int fq) const {
        const int row0 = u.pm * BM + wr * 64 + fr, col0 = u.pn * BM + wc * 32 + 4 * fq;
#pragma unroll
        for (int ai = 0; ai < 2; ++ai)
#pragma unroll
            for (int m = 0; m < 4; ++m) { float* rowp = O + (size_t)(row0 + ai * HALF + m * 16) * ldc + col0;
#pragma unroll
                for (int bj = 0; bj < 2; ++bj)
#pragma unroll
                    for (int n = 0; n < 2; ++n) *(f32x4*)(rowp + bj * HALF + n * 16) = acc[ai][bj][m][n]; }
    }
};
template <class Epi, class Sched, bool ALIGN_EPI = false, bool SP2 = false>
__device__ __forceinline__ void gemm_phase(PG8_LAS unsigned char* lds, const Gemm g, const Sched& S, const Epi& E) {
    const int tid = threadIdx.x, wid = __builtin_amdgcn_readfirstlane(tid >> 6), lane = tid & 63, wr = wid >> 2, wc = wid & 3, fr = lane & 15, fq = lane >> 4;
    const int K = g.K, nt = K / BK;
    unsigned voffA[2], voffB[2];
#pragma unroll
    for (int i = 0; i < 2; ++i) { int R, C; stage_rc(tid * 16 + i * 8192, R, C); const int Rb = Epi::PERM ? ((R & ~31) + perm32(R & 31)) : R;
        voffA[i] = (unsigned)(R * K + C) * 2u; voffB[i] = (unsigned)(Rb * K + C) * 2u; }
    const size_t kstep = (size_t)(BK * 2);
    const size_t hstep = (size_t)HALF * K * 2;
    const size_t tstep = 2 * hstep;
    const unsigned ldsw = (unsigned)wid * 1024u;
    const int aoff = lds_byte(wr * 64 + fr, fq * 8), boff = lds_byte(wc * 32 + fr, fq * 8);
#define PG8_SA(b, h) (((b) * 2 + (h)) * HTB)
#define PG8_SB(b, h) ((4 + (b) * 2 + (h)) * HTB)
#define PG8_STAGE(bufoff, gbase, voff) do { _Pragma("unroll") for (int _i = 0; _i < 2; ++_i) \
        __builtin_amdgcn_global_load_lds((const unsigned*)((const char*)(gbase) + (voff)[_i]), (PG8_LAS unsigned*)(lds + (bufoff) + ldsw + _i * 8192), 16, 0, 0); } while (0)
#define PG8_LDA(dst, b, h) do { _Pragma("unroll") for (int m = 0; m < 4; ++m) _Pragma("unroll") for (int k = 0; k < 2; ++k) dst[m][k] = *(const PG8_LAS bf16x8*)(lds + PG8_SA(b, h) + aoff + m * 2048 + k * 1024); } while (0)
#define PG8_LDB(dst, b, h) do { _Pragma("unroll") for (int n = 0; n < 2; ++n) _Pragma("unroll") for (int k = 0; k < 2; ++k) dst[n][k] = *(const PG8_LAS bf16x8*)(lds + PG8_SB(b, h) + boff + n * 2048 + k * 1024); } while (0)
#define PG8_MMA(ai, bj, At, Bt) do { __builtin_amdgcn_s_setprio(1); _Pragma("unroll") for (int m = 0; m < 4; ++m) _Pragma("unroll") for (int n = 0; n < 2; ++n) _Pragma("unroll") for (int k = 0; k < 2; ++k) \
        acc[ai][bj][m][n] = __builtin_amdgcn_mfma_f32_16x16x32_bf16(Bt[n][k], At[m][k], acc[ai][bj][m][n], 0, 0, 0); __builtin_amdgcn_s_setprio(0); } while (0)
#define PG8_WAIT_V(n) asm volatile("s_waitcnt vmcnt(" #n ")" ::: "memory")
#define PG8_WAIT_L(n) asm volatile("s_waitcnt lgkmcnt(" #n ")" ::: "memory")
#define PG8_BAR __builtin_amdgcn_s_barrier()
#define PG8_SCHED __builtin_amdgcn_sched_barrier(0)
    Unit cur, nxt; int ui = 0;
    if (!S.next(0, cur)) return;
    f32x4 acc[2][2][4][2];
#pragma unroll
    for (int a = 0; a < 2; ++a)
#pragma unroll
        for (int b = 0; b < 2; ++b)
#pragma unroll
            for (int m = 0; m < 4; ++m)
#pragma unroll
                for (int n = 0; n < 2; ++n) acc[a][b][m][n] = (f32x4){0.f, 0.f, 0.f, 0.f};
    bf16x8 At[4][2], B0[2][2], B1[2][2];
    const char* cA = (const char*)g.A + (size_t)cur.pm * tstep; const char* cB = (const char*)g.Bt + (size_t)cur.pn * tstep;
    S.a_ready(cur);
    if constexpr (SP2) {
        PG8_STAGE(PG8_SB(0, 0), cB, voffB); PG8_STAGE(PG8_SB(0, 1), cB + hstep, voffB); PG8_STAGE(PG8_SA(0, 0), cA, voffA); PG8_STAGE(PG8_SA(0, 1), cA + hstep, voffA);
        if (wr == 1) PG8_BAR;
        PG8_WAIT_V(2); PG8_BAR;
        PG8_STAGE(PG8_SB(1, 0), cB + kstep, voffB); PG8_STAGE(PG8_SA(1, 0), cA + kstep, voffA); PG8_STAGE(PG8_SB(1, 1), cB + hstep + kstep, voffB);
        PG8_WAIT_V(6); PG8_BAR;
    } else {
        PG8_STAGE(PG8_SB(0, 0), cB, voffB); PG8_STAGE(PG8_SA(0, 0), cA, voffA); PG8_STAGE(PG8_SB(0, 1), cB + hstep, voffB); PG8_STAGE(PG8_SA(0, 1), cA + hstep, voffA);
        if (wr == 1) PG8_BAR;
        PG8_WAIT_V(4); PG8_BAR;
        PG8_STAGE(PG8_SB(1, 0), cB + kstep, voffB); PG8_STAGE(PG8_SA(1, 0), cA + kstep, voffA); PG8_STAGE(PG8_SB(1, 1), cB + hstep + kstep, voffB);
        PG8_WAIT_V(6); PG8_BAR;
    }
    for (;;) {
        const bool has_next = S.next(ui + 1, nxt);
        const char* nA = has_next ? (const char*)g.A + (size_t)nxt.pm * tstep : cA; const char* nB = has_next ? (const char*)g.Bt + (size_t)nxt.pn * tstep : cB;
        for (int t = 0; t < nt; t += 2) {
            const bool last = (t == nt - 2);
            const char* a1 = cA + (size_t)(t + 1) * kstep;
            const char* a2 = last ? nA : cA + (size_t)(t + 2) * kstep; const char* b2 = last ? nB : cB + (size_t)(t + 2) * kstep;
            const char* a3 = a2 + kstep; const char* b3 = b2 + kstep;
            if (last && has_next) S.a_ready(nxt);
            if constexpr (SP2) {
            PG8_LDB(B0, 0, 0); PG8_LDB(B1, 0, 1); PG8_SCHED; PG8_LDA(At, 0, 0); PG8_STAGE(PG8_SA(1, 1), a1 + hstep, voffA);
            PG8_WAIT_V(8); PG8_WAIT_L(0); PG8_BAR; PG8_MMA(0, 0, At, B0); PG8_MMA(0, 1, At, B1); PG8_BAR; PG8_SCHED;
            PG8_LDA(At, 0, 1); PG8_STAGE(PG8_SB(0, 0), b2, voffB); PG8_STAGE(PG8_SB(0, 1), b2 + hstep, voffB); PG8_STAGE(PG8_SA(0, 0), a2, voffA);
            PG8_WAIT_V(8); PG8_WAIT_L(0); PG8_BAR; PG8_MMA(1, 0, At, B0); PG8_MMA(1, 1, At, B1); PG8_BAR; PG8_SCHED;
            PG8_LDB(B0, 1, 0); PG8_LDB(B1, 1, 1); PG8_SCHED; PG8_LDA(At, 1, 0); PG8_STAGE(PG8_SA(0, 1), a2 + hstep, voffA);
            PG8_WAIT_V(8); PG8_WAIT_L(0); PG8_BAR; PG8_MMA(0, 0, At, B0); PG8_MMA(0, 1, At, B1); PG8_BAR; PG8_SCHED;
            PG8_LDA(At, 1, 1); PG8_STAGE(PG8_SB(1, 0), b3, voffB); PG8_STAGE(PG8_SB(1, 1), b3 + hstep, voffB); PG8_STAGE(PG8_SA(1, 0), a3, voffA);
            PG8_WAIT_V(8); PG8_WAIT_L(0); PG8_BAR; PG8_MMA(1, 0, At, B0); PG8_MMA(1, 1, At, B1); PG8_BAR; PG8_SCHED;
            } else {
            PG8_LDB(B0, 0, 0); PG8_SCHED; PG8_LDA(At, 0, 0); PG8_STAGE(PG8_SA(1, 1), a1 + hstep, voffA);
            PG8_WAIT_L(8); PG8_BAR; PG8_WAIT_L(0); PG8_MMA(0, 0, At, B0); PG8_BAR; PG8_SCHED;
            PG8_LDB(B1, 0, 1); PG8_STAGE(PG8_SB(0, 0), b2, voffB);
            PG8_BAR; PG8_WAIT_L(0); PG8_MMA(0, 1, At, B1); PG8_BAR;
            PG8_LDA(At, 0, 1); PG8_STAGE(PG8_SA(0, 0), a2, voffA);
            PG8_BAR; PG8_WAIT_L(0); PG8_MMA(1, 0, At, B0); PG8_BAR; PG8_SCHED;
            PG8_STAGE(PG8_SB(0, 1), b2 + hstep, voffB);
            PG8_WAIT_V(6); PG8_BAR; PG8_MMA(1, 1, At, B1); PG8_BAR;
            PG8_LDB(B0, 1, 0); PG8_SCHED; PG8_LDA(At, 1, 0); PG8_STAGE(PG8_SA(0, 1), a2 + hstep, voffA);
            PG8_WAIT_L(8); PG8_BAR; PG8_WAIT_L(0); PG8_MMA(0, 0, At, B0); PG8_BAR; PG8_SCHED;
            PG8_LDB(B1, 1, 1); PG8_STAGE(PG8_SB(1, 0), b3, voffB);
            PG8_BAR; PG8_WAIT_L(0); PG8_MMA(0, 1, At, B1); PG8_BAR;
            PG8_LDA(At, 1, 1); PG8_STAGE(PG8_SA(1, 0), a3, voffA);
            PG8_BAR; PG8_WAIT_L(0); PG8_MMA(1, 0, At, B0); PG8_BAR; PG8_SCHED;
            PG8_STAGE(PG8_SB(1, 1), b3 + hstep, voffB);
            PG8_WAIT_V(6); PG8_BAR; PG8_MMA(1, 1, At, B1); PG8_BAR;
            }
        }
        if constexpr (ALIGN_EPI) { if (wr == 0) PG8_BAR; }
        if constexpr (!Epi::AFTER_DRAIN) { E(acc, cur, wr, wc, fr, fq); S.done(cur); }
        if (!has_next) break;
#pragma unroll
        for (int a = 0; a < 2; ++a)
#pragma unroll
            for (int b = 0; b < 2; ++b)
#pragma unroll
                for (int m = 0; m < 4; ++m)
#pragma unroll
                    for (int n = 0; n < 2; ++n) acc[a][b][m][n] = (f32x4){0.f, 0.f, 0.f, 0.f};
        cur = nxt; cA = nA; cB = nB; ++ui;
        if constexpr (ALIGN_EPI) { if (wr == 1) PG8_BAR; }
    }
    PG8_WAIT_V(0);
    if constexpr (!ALIGN_EPI) { if (wr == 0) PG8_BAR; }
    PG8_BAR;
    if constexpr (Epi::AFTER_DRAIN) { E.fused(acc, cur, wr, wc, fr, fq, lds, wid, lane); S.done(cur); }
#undef PG8_SA
#undef PG8_SB
#undef PG8_STAGE
#undef PG8_LDA
#undef PG8_LDB
#undef PG8_MMA
#undef PG8_WAIT_V
#undef PG8_WAIT_L
#undef PG8_BAR
#undef PG8_SCHED
}
}

#define DI __device__ __forceinline__
constexpr int NWAVES = 8;
#ifndef MK_N_LAUNCHES
#define MK_N_LAUNCHES 1
#endif
constexpr int N_PHASES = 10;
constexpr int N_LAUNCHES = MK_N_LAUNCHES;
constexpr int D = 1024, MP = 16384, MS = 512, M = MP + MS, NIN = 6656, FF = 4096, S5W = 512;
constexpr int SEQ = 2048, NB = 8, DB = 128, DSEQ = 4;
constexpr int SG = 32, SN = 64, SC = 16;
constexpr int HH = 8, DK = 128, DV = 128;
constexpr float EPS = 1e-6f;
constexpr size_t O_Y = 0, O_S5RP = (size_t)M * D, O_S5IP = O_S5RP + NB * SG * SN, O_HGP = O_S5IP + NB * SG * SN, O_S5RS = O_HGP + (size_t)NB * HH * DK * DV,
                 O_S5IS = O_S5RS + (size_t)DB * SG * SN, O_HGS = O_S5IS + (size_t)DB * SG * SN, O_END = O_HGS + (size_t)DB * HH * DK * DV;
constexpr size_t MiB = 1u << 20, HMiB = 1u << 19;
constexpr size_t WS_CTL = 0, CTL_ZERO_BYTES = 1 * MiB;
constexpr size_t WS_WIN = 1 * MiB, WS_WGLU = 14 * MiB, WS_WBRS = 14 * MiB + HMiB, WS_WBRH = 15 * MiB + HMiB, WS_WOUT = 17 * MiB + HMiB, WS_WUP = 19 * MiB + HMiB, WS_WDN = 27 * MiB + HMiB;
constexpr size_t WS_KC = 35 * MiB + HMiB, WS_VOUT = 36 * MiB, WS_WEND = 38 * MiB, WS_WEND4 = 40 * MiB, WS_APOW = 40 * MiB + HMiB;
constexpr size_t WS_XN = 41 * MiB, WS_U = 74 * MiB, WS_S0 = 90 * MiB + HMiB, WS_S1 = WS_S0 + 33 * MiB, WS_S2 = WS_S1 + 33 * MiB, WS_S3 = WS_S2 + 33 * MiB;
constexpr size_t WS_YG = WS_XN, WS_YS5 = WS_XN + 16 * MiB + HMiB, WS_RAW1 = WS_S0, WS_YH = WS_S3 + 33 * MiB, WS_HMID = WS_XN, WS_RAW2 = 173 * MiB, WS_END = 256 * MiB;
static_assert((size_t)M * D * 2 == 33 * MiB && WS_S3 + 33 * MiB <= WS_END && WS_HMID + (size_t)M * FF * 2 <= WS_S3 && WS_RAW2 + (size_t)M * D * 4 <= WS_END && WS_RAW2 >= WS_HMID + (size_t)M * FF * 2, "d_ws map");
constexpr int CW_TMO = 0, CW_CODE = 1, CW_BAR = 4096;
constexpr int RING_BYTES = 131072, LDSCTL_OFF = RING_BYTES, MISC_OFF = LDSCTL_OFF + 320, LDS_BYTES = 147456;

#define GAS __attribute__((address_space(1)))
#define LAS __attribute__((address_space(3)))
typedef unsigned short bf16;
typedef unsigned v4u __attribute__((ext_vector_type(4)));
typedef float f32x4 __attribute__((ext_vector_type(4)));
typedef short bf16x8 __attribute__((ext_vector_type(8)));
typedef GAS unsigned gu32;
typedef GAS unsigned long long gu64;
#define RLX_AGENT __ATOMIC_RELAXED, __HIP_MEMORY_SCOPE_AGENT
#define LDS_WAIT() asm volatile("s_waitcnt lgkmcnt(0)" ::: "memory")
#define VM_WAIT() asm volatile("s_waitcnt vmcnt(0)" ::: "memory")
__device__ __forceinline__ unsigned long long rt() { return __builtin_amdgcn_s_memrealtime(); }
__device__ __forceinline__ unsigned f2bf(float f) { unsigned u = __builtin_bit_cast(unsigned, f); return (u + 0x7fffu + ((u >> 16) & 1u)) >> 16; }
__device__ __forceinline__ unsigned pk2(float lo, float hi) { return f2bf(lo) | (f2bf(hi) << 16); }
#define XB_TMO      128
#define XB_XCNT(j)  (256  + 64 * (j))
#define XB_XSUB(j)  (1280 + 64 * (j))
#define XB_XGEN(j)  (2304 + 64 * (j))
#define XB_TOP      3328
#define XB_TOPGEN   3392
#define XCD_BAR_WORDS 3456
#define XB_SPIN_CAP (1u << 18)

__device__ __forceinline__ unsigned xb_ld(unsigned* p)              { return __hip_atomic_load(p, __ATOMIC_RELAXED, __HIP_MEMORY_SCOPE_AGENT); }
__device__ __forceinline__ unsigned xb_add(unsigned* p, unsigned v) { return __hip_atomic_fetch_add(p, v, __ATOMIC_RELAXED, __HIP_MEMORY_SCOPE_AGENT); }
__device__ __forceinline__ unsigned xb_xcc_id() { return (unsigned)__builtin_amdgcn_s_getreg((3 << 11) | 20) & 0xFu; }
#define XB_SPIN(cond, bar) do { unsigned _sp = 0; while (cond) { __builtin_amdgcn_s_sleep(1); \
    if ((++_sp & 255u) == 0u) { if (xb_ld(&(bar)[XB_TMO])) break; if (_sp > XB_SPIN_CAP) { atomicAdd(&(bar)[XB_TMO], 1u); break; } } } } while (0)

struct XcdBarrier {
    unsigned* bar; unsigned x;
    volatile LAS unsigned* st;
};

__device__ __forceinline__ XcdBarrier xcd_barrier_post(unsigned* bar, volatile LAS unsigned* st) {
    XcdBarrier b; b.bar = bar; b.x = xb_xcc_id(); b.st = st;
    if (threadIdx.x == 0) (void)xb_add(&bar[XB_XCNT(b.x)], 1u);
    return b;
}
__device__ __forceinline__ void xcd_barrier_complete(unsigned* bar, unsigned x, unsigned& nloc, unsigned& nx) {
    const unsigned G = gridDim.x * gridDim.y * gridDim.z;
    unsigned sum, cnt, mine, sp = 0u;
    for (;;) {
        sum = 0u; cnt = 0u; mine = 0u;
#pragma unroll
        for (unsigned j = 0; j < 16; ++j) { const unsigned c = xb_ld(&bar[XB_XCNT(j)]); sum += c; cnt += (c > 0u) ? 1u : 0u; mine = (j == x) ? c : mine; }
        if (sum == G) break;
        __builtin_amdgcn_s_sleep(1);
        if ((++sp & 255u) == 0u) { if (xb_ld(&bar[XB_TMO])) break; if (sp > XB_SPIN_CAP) { atomicAdd(&bar[XB_TMO], 1u); break; } }
    }
    nloc = mine > 0u ? mine : 1u; nx = cnt > 0u ? cnt : 1u;
}

__device__ __forceinline__ void xcd_barrier(const XcdBarrier& b) {
    asm volatile("s_waitcnt vmcnt(0)" ::: "memory");
    __syncthreads();
    if (threadIdx.x == 0) {
        unsigned* bar = b.bar;
        __builtin_amdgcn_s_waitcnt(0);
        unsigned nloc = b.st[0], nx = b.st[1];
        if (nloc == 0u) { xcd_barrier_complete(bar, b.x, nloc, nx); b.st[0] = nloc; b.st[1] = nx; }
        const unsigned old = xb_add(&bar[XB_XSUB(b.x)], 1u);
        const unsigned gen = old / nloc;
        if (old + 1u == (gen + 1u) * nloc) {
            __builtin_amdgcn_fence(__ATOMIC_RELEASE, "agent");
            asm volatile("s_waitcnt vmcnt(0)" ::: "memory");
            const unsigned og = xb_add(&bar[XB_TOP], 1u);
            const unsigned tg = og / nx;
            if (og + 1u == (tg + 1u) * nx) xb_add(&bar[XB_TOPGEN], 1u);
            else XB_SPIN(xb_ld(&bar[XB_TOPGEN]) == tg, bar);
            __builtin_amdgcn_fence(__ATOMIC_ACQUIRE, "agent");
            xb_add(&bar[XB_XGEN(b.x)], 1u);
            asm volatile("s_waitcnt vmcnt(0)" ::: "memory");
        } else {
            XB_SPIN(xb_ld(&bar[XB_XGEN(b.x)]) == gen, bar);
            __builtin_amdgcn_fence(__ATOMIC_ACQUIRE, "agent");
            asm volatile("s_waitcnt vmcnt(0)" ::: "memory");
        }
    }
    __syncthreads();
}

typedef short s16x4 __attribute__((ext_vector_type(4)));
typedef float f32x16 __attribute__((ext_vector_type(16)));
typedef unsigned v2u __attribute__((ext_vector_type(2)));
using pg8::bf2f; using pg8::bflo; using pg8::bfhi; using pg8::sigm; using pg8::siluf; using pg8::gelu_tanh; using pg8::frcp; using pg8::cvt_pk_bf16;
#define MFMA32(a, b, c) __builtin_amdgcn_mfma_f32_32x32x16_bf16((a), (b), (c), 0, 0, 0)
#define MFMA16(a, b, c) __builtin_amdgcn_mfma_f32_16x16x32_bf16((a), (b), (c), 0, 0, 0)
struct Frame {
    LAS unsigned char* lds; volatile LAS unsigned* MISC; gu32* ctl;
    int tid, lane, wave, vcu, G;
    const float* in[28]; float* out; unsigned char* ws;
};
DI float wave_sum(float v) {
#pragma unroll
    for (int o = 1; o < 64; o <<= 1) v += __shfl_xor(v, o);
    return v;
}
DI const float* xrow(const Frame& F, int m) { return m < MP ? F.in[0] + (size_t)m * D : F.in[1] + (size_t)(m - MP) * D; }
DI bf16x8 zero8() { return (bf16x8){0, 0, 0, 0, 0, 0, 0, 0}; }
DI f32x16 zero16() { f32x16 z;
#pragma unroll
    for (int i = 0; i < 16; ++i) z[i] = 0.f;
    return z; }
DI bf16x8 ldg8(const bf16* p) { return *(const GAS bf16x8*)p; }
DI bf16x8 pack8(float a0, float a1, float a2, float a3, float a4, float a5, float a6, float a7) {
    v4u w; w.x = cvt_pk_bf16(a0, a1); w.y = cvt_pk_bf16(a2, a3); w.z = cvt_pk_bf16(a4, a5); w.w = cvt_pk_bf16(a6, a7); return __builtin_bit_cast(bf16x8, w); }

DI void p0_transpose_item(const float* W, int K, int N, bf16* WT, LAS float* scr, int item, int lane) {
    const int nblk = N / 32, kb = item / nblk, nb = item % nblk, k0 = 64 * kb, n0 = 32 * nb;
#pragma unroll 8
    for (int i = 0; i < 32; ++i) { const int kk = 2 * i + (lane >> 5); scr[kk * 33 + (lane & 31)] = W[(size_t)(k0 + kk) * N + n0 + (lane & 31)]; }
    LDS_WAIT(); asm volatile("" ::: "memory");
    const int c = lane & 7;
#pragma unroll
    for (int j = 0; j < 4; ++j) { const int n = (lane >> 3) + 8 * j; const LAS float* s = scr + (8 * c) * 33 + n;
        v4u o; o.x = pk2(s[0 * 33], s[1 * 33]); o.y = pk2(s[2 * 33], s[3 * 33]); o.z = pk2(s[4 * 33], s[5 * 33]); o.w = pk2(s[6 * 33], s[7 * 33]);
        *(GAS v4u*)(WT + (size_t)(n0 + n) * K + k0 + 8 * c) = o; }
    LDS_WAIT(); asm volatile("" ::: "memory");
}
DI void rms_row_to_bf16(const Frame& F, const float* xr_, const float* g, bf16* orow) {
    const GAS f32x4* xr = (const GAS f32x4*)xr_ + F.lane; const GAS f32x4* gr = (const GAS f32x4*)g + F.lane;
    f32x4 v[4]; float s = 0.f;
#pragma unroll
    for (int j = 0; j < 4; ++j) { v[j] = xr[64 * j]; s += (v[j].x * v[j].x + v[j].y * v[j].y) + (v[j].z * v[j].z + v[j].w * v[j].w); }
    const float rstd = 1.f / sqrtf(wave_sum(s) * (1.f / D) + EPS);
    GAS unsigned long long* o8 = (GAS unsigned long long*)orow + F.lane;
#pragma unroll
    for (int j = 0; j < 4; ++j) { const f32x4 gg = gr[64 * j];
        o8[64 * j] = (unsigned long long)pk2(v[j].x * rstd * gg.x, v[j].y * rstd * gg.y) | ((unsigned long long)pk2(v[j].z * rstd * gg.z, v[j].w * rstd * gg.w) << 32); }
}
DI void p0_s5_item(Frame& F, int g, int j) {
    LAS float* L = (LAS float*)F.lds;
    LAS float* PW = L; LAS float* BB = L + 1024;
    const float* a_re = F.in[11]; const float* a_im = F.in[12]; const float* log_dt = F.in[13];
    const float* b_re = F.in[14]; const float* b_im = F.in[15]; const float* c_re = F.in[16]; const float* c_im = F.in[17];
    const int tid = F.tid;
    if (tid < 64) { const int n = tid; const float are = a_re[g * SN + n], aim = a_im[g * SN + n], dt = expf(log_dt[g]);
        float sn, cs, sh, ch; sincosf(dt * aim, &sn, &cs); sincosf(0.5f * dt * aim, &sh, &ch);
        const float mag = expf(dt * are), abi = mag * sn;
        const float nr = expm1f(dt * are) - 2.0f * mag * sh * sh, ni = abi, den = are * are + aim * aim;
        PW[2 * n] = (nr * are + ni * aim) / den; PW[2 * n + 1] = (ni * are - nr * aim) / den;
        const int e4 = j < 4 ? 3 - j : 0; const int ex[4] = {j, j + 1, 15 - j, e4};
#pragma unroll
        for (int q = 0; q < 4; ++q) { float s2, c2; const float m2 = expf((float)ex[q] * dt * are); sincosf((float)ex[q] * dt * aim, &s2, &c2);
            PW[128 * (q + 1) + 2 * n] = m2 * c2; PW[128 * (q + 1) + 2 * n + 1] = m2 * s2; }
        if (j == 0) { float s4, c4; const float m4 = expf(4.0f * dt * are); sincosf(4.0f * dt * aim, &s4, &c4); ((float*)(F.ws + WS_APOW))[2 * (g * SN + n)] = m4 * c4; ((float*)(F.ws + WS_APOW))[2 * (g * SN + n) + 1] = m4 * s4; }
    }
    __syncthreads();
    for (int e = tid; e < SN * SC; e += NWAVES * 64) { const int n = e >> 4; const float cr = PW[2 * n], ci = PW[2 * n + 1], br = b_re[(size_t)g * SN * SC + e], bi = b_im[(size_t)g * SN * SC + e];
        BB[2 * e] = cr * br - ci * bi; BB[2 * e + 1] = cr * bi + ci * br; }
    __syncthreads();
    bf16* KC = (bf16*)(F.ws + WS_KC); bf16* VO = (bf16*)(F.ws + WS_VOUT); bf16* WE = (bf16*)(F.ws + WS_WEND); bf16* W4 = (bf16*)(F.ws + WS_WEND4);
    if (tid < 256) { const int co = tid >> 4, ci = tid & 15; float acc = 0.f;
        for (int n = 0; n < SN; ++n) { const float cr = c_re[((size_t)g * SC + co) * SN + n], cim = c_im[((size_t)g * SC + co) * SN + n];
            const float ar = PW[128 + 2 * n], ai = PW[128 + 2 * n + 1], br = BB[2 * (n * 16 + ci)], bi = BB[2 * (n * 16 + ci) + 1];
            const float xr = ar * br - ai * bi, xi = ar * bi + ai * br; acc += cr * xr - cim * xi; }
        KC[(((size_t)g * 16 + j) * 16 + co) * 16 + ci] = (bf16)f2bf(acc); }
    for (int e = tid; e < 16 * 128; e += NWAVES * 64) { const int co = e >> 7, np = e & 127, n = np & 63;
        const float cr = c_re[((size_t)g * SC + co) * SN + n], cim = c_im[((size_t)g * SC + co) * SN + n], ar = PW[256 + 2 * n], ai = PW[256 + 2 * n + 1];
        const float v = np < 64 ? (cr * ar - cim * ai) : -(cr * ai + cim * ar);
        VO[(((size_t)g * 16 + j) * 16 + co) * 128 + np] = (bf16)f2bf(v); }
    for (int e = tid; e < 128 * 16; e += NWAVES * 64) { const int np = e >> 4, ci = e & 15, n = np & 63;
        const float br = BB[2 * (n * 16 + ci)], bi = BB[2 * (n * 16 + ci) + 1];
        { const float ar = PW[384 + 2 * n], ai = PW[384 + 2 * n + 1]; const float v = np < 64 ? (ar * br - ai * bi) : (ar * bi + ai * br);
          WE[((size_t)g * 128 + np) * 256 + j * 16 + ci] = (bf16)f2bf(v); }
        if (j < 4) { const float ar = PW[512 + 2 * n], ai = PW[512 + 2 * n + 1]; const float v = np < 64 ? (ar * br - ai * bi) : (ar * bi + ai * br);
          W4[((size_t)g * 128 + np) * 64 + j * 16 + ci] = (bf16)f2bf(v); } }
    __syncthreads();
}
DI void p0_prologue(Frame& F) {
    for (int it = F.vcu; it < SG * 16; it += F.G) p0_s5_item(F, it >> 4, it & 15);
    LAS float* scr = (LAS float*)(F.lds + F.wave * 16384);
    const int gw = F.vcu * NWAVES + F.wave, NGW = F.G * NWAVES;
    constexpr int I_IN = (D / 64) * (NIN / 32), I_GLU = (S5W / 64) * (S5W / 32), I_BRS = (S5W / 64) * (D / 32), I_BRH = (D / 64) * (D / 32), I_OUT = I_BRH, I_UP = (D / 64) * (FF / 32), I_DN = (FF / 64) * (D / 32);
    constexpr int NITEMS = I_IN + I_GLU + I_BRS + I_BRH + I_OUT + I_UP + I_DN;
    for (int it = gw; it < NITEMS; it += NGW) {
        int r = it;
        if (r < I_IN) { p0_transpose_item(F.in[9], D, NIN, (bf16*)(F.ws + WS_WIN), scr, r, F.lane); continue; } r -= I_IN;
        if (r < I_GLU) { p0_transpose_item(F.in[19], S5W, S5W, (bf16*)(F.ws + WS_WGLU), scr, r, F.lane); continue; } r -= I_GLU;
        if (r < I_BRS) { p0_transpose_item(F.in[23], S5W, D, (bf16*)(F.ws + WS_WBRS), scr, r, F.lane); continue; } r -= I_BRS;
        if (r < I_BRH) { p0_transpose_item(F.in[24], D, D, (bf16*)(F.ws + WS_WBRH), scr, r, F.lane); continue; } r -= I_BRH;
        if (r < I_OUT) { p0_transpose_item(F.in[25], D, D, (bf16*)(F.ws + WS_WOUT), scr, r, F.lane); continue; } r -= I_OUT;
        if (r < I_UP) { p0_transpose_item(F.in[26], D, FF, (bf16*)(F.ws + WS_WUP), scr, r, F.lane); continue; } r -= I_UP;
        p0_transpose_item(F.in[27], FF, D, (bf16*)(F.ws + WS_WDN), scr, r, F.lane);
    }
    bf16* XN = (bf16*)(F.ws + WS_XN);
    for (int m = gw; m < M; m += NGW) rms_row_to_bf16(F, xrow(F, m), F.in[5], XN + (size_t)m * D);
}
constexpr int S5_HEND = 0, S5_HC = 128 * 132 * 4, S5_E = S5_HC + 128 * 136 * 2;
DI float gelu_du(float acc, float d, float u) { return gelu_tanh(acc + d * u); }
DI void s5_y_store(const Frame& F, const f32x16& acc, int g, int tok0, int t0, int h) {
    const bf16* U = (const bf16*)(F.ws + WS_U); bf16* YG = (bf16*)(F.ws + WS_YG); const float* dvec = F.in[18];
#pragma unroll
    for (int rq = 0; rq < 4; ++rq) { const int tl = rq >> 1, ch = g * SC + 8 * (rq & 1) + 4 * h; const size_t off = (size_t)(tok0 + t0 + tl) * S5W + ch;
        const v2u uu = *(const GAS v2u*)(U + off); const f32x4 dd = *(const GAS f32x4*)(dvec + ch);
        const float y0 = gelu_du(acc[4 * rq + 0], dd.x, bflo(uu.x)), y1 = gelu_du(acc[4 * rq + 1], dd.y, bfhi(uu.x)), y2 = gelu_du(acc[4 * rq + 2], dd.z, bflo(uu.y)), y3 = gelu_du(acc[4 * rq + 3], dd.w, bfhi(uu.y));
        v2u o; o.x = cvt_pk_bf16(y0, y1); o.y = cvt_pk_bf16(y2, y3); *(GAS v2u*)(YG + off) = o; }
}
DI void s5_chain(Frame& F, int g, int b, int sub) {
    const int lane = F.lane, w = F.wave, r = lane & 31, h = lane >> 5;
    const bf16* U = (const bf16*)(F.ws + WS_U); const bf16* KC = (const bf16*)(F.ws + WS_KC); const bf16* VO = (const bf16*)(F.ws + WS_VOUT);
    const bf16* WE = (const bf16*)(F.ws + WS_WEND); const bf16* W4 = (const bf16*)(F.ws + WS_WEND4);
    LAS float* HEND = (LAS float*)(F.lds + S5_HEND); LAS unsigned char* HC = F.lds + S5_HC; LAS float* E = (LAS float*)(F.lds + S5_E);
    {
        const int mt = w & 3, half = w >> 2;
        bf16x8 wa[16];
#pragma unroll
        for (int ks = 0; ks < 16; ++ks) wa[ks] = ldg8(WE + ((size_t)g * 128 + 32 * mt + r) * 256 + 16 * ks + 8 * h);
#pragma unroll 1
        for (int cti = 0; cti < 2; ++cti) { const int chunk = 32 * (2 * half + cti) + r; const bf16* up = U + ((size_t)b * SEQ + chunk * 16) * S5W + g * SC + 8 * h;
            f32x16 acc = zero16();
#pragma unroll
            for (int ks = 0; ks < 16; ++ks) acc = MFMA32(wa[ks], ldg8(up + (size_t)ks * S5W), acc);
#pragma unroll
            for (int rq = 0; rq < 4; ++rq) *(LAS f32x4*)(HEND + chunk * 132 + 32 * mt + 8 * rq + 4 * h) = (f32x4){acc[4 * rq], acc[4 * rq + 1], acc[4 * rq + 2], acc[4 * rq + 3]};
        }
    }
    __syncthreads();
    {
        const int n = lane, seg = w; const float are = F.in[11][g * SN + n], aim = F.in[12][g * SN + n], dt = expf(F.in[13][g]);
        float s16, c16, s256, c256; sincosf(16.0f * dt * aim, &s16, &c16); sincosf(256.0f * dt * aim, &s256, &c256);
        const float m16 = expf(16.0f * dt * are), m256 = expf(256.0f * dt * are);
        const float ar = m16 * c16, ai = m16 * s16, Ar = m256 * c256, Ai = m256 * s256;
        float lr[16], li[16]; float xr = 0.f, xi = 0.f;
#pragma unroll
        for (int j = 0; j < 16; ++j) { lr[j] = xr; li[j] = xi; const float er = HEND[(16 * seg + j) * 132 + n], ei = HEND[(16 * seg + j) * 132 + 64 + n];
            const float nr = ar * xr - ai * xi + er, ni = ar * xi + ai * xr + ei; xr = nr; xi = ni; }
        E[(seg * 64 + n) * 2] = xr; E[(seg * 64 + n) * 2 + 1] = xi;
        __syncthreads();
        float Sr = 0.f, Si = 0.f;
        for (int s2 = 0; s2 < seg; ++s2) { const float er = E[(s2 * 64 + n) * 2], ei = E[(s2 * 64 + n) * 2 + 1]; const float nr = Ar * Sr - Ai * Si + er, ni = Ar * Si + Ai * Sr + ei; Sr = nr; Si = ni; }
        float pr = 1.f, pi = 0.f;
#pragma unroll
        for (int j = 0; j < 16; ++j) { const float hr = lr[j] + pr * Sr - pi * Si, hi = li[j] + pr * Si + pi * Sr;
            *(LAS bf16*)(HC + (16 * seg + j) * 272 + n * 2) = (bf16)f2bf(hr); *(LAS bf16*)(HC + (16 * seg + j) * 272 + (64 + n) * 2) = (bf16)f2bf(hi);
            const float qr = pr * ar - pi * ai, qi = pr * ai + pi * ar; pr = qr; pi = qi; }
        if (seg == 7) { F.out[O_S5RP + ((size_t)b * SG + g) * SN + n] = xr + pr * Sr - pi * Si; F.out[O_S5IP + ((size_t)b * SG + g) * SN + n] = xi + pr * Si + pi * Sr; }
    }
    __syncthreads();
    {
        const int tl = r >> 4, co = r & 15, t = 2 * w + tl;
        bf16x8 ka[16], va[8];
#pragma unroll
        for (int ks = 0; ks < 16; ++ks) { const int lag = t - ks; ka[ks] = lag >= 0 ? ldg8(KC + (((size_t)g * 16 + lag) * 16 + co) * 16 + 8 * h) : zero8(); }
#pragma unroll
        for (int kc = 0; kc < 8; ++kc) va[kc] = ldg8(VO + (((size_t)g * 16 + t) * 16 + co) * 128 + 16 * kc + 8 * h);
#pragma unroll 1
        for (int ct = 0; ct < 4; ++ct) { const int chunk = 32 * ct + r, tok0 = b * SEQ + chunk * 16; const bf16* up = U + (size_t)tok0 * S5W + g * SC + 8 * h;
            f32x16 acc = zero16();
#pragma unroll
            for (int ks = 0; ks < 16; ++ks) if (ks <= 2 * w + 1) acc = MFMA32(ka[ks], ldg8(up + (size_t)ks * S5W), acc);
#pragma unroll
            for (int kc = 0; kc < 8; ++kc) acc = MFMA32(va[kc], *(const LAS bf16x8*)(HC + chunk * 272 + (16 * kc + 8 * h) * 2), acc);
            s5_y_store(F, acc, g, tok0, 2 * w, h);
        }
        if (sub >= 0) { const int bs = 32 * sub + r, tok0 = MP + 4 * bs; const bf16* up = U + (size_t)tok0 * S5W + g * SC + 8 * h;
            const float* h0r = F.in[2] + ((size_t)bs * SG + g) * SN; const float* h0i = F.in[3] + ((size_t)bs * SG + g) * SN;
            if (w < 2) { f32x16 acc = zero16();
#pragma unroll
                for (int ks = 0; ks < 4; ++ks) if (ks <= 2 * w + 1) acc = MFMA32(ka[ks], ldg8(up + (size_t)ks * S5W), acc);
#pragma unroll
                for (int kc = 0; kc < 8; ++kc) { const float* src = (kc < 4 ? h0r : h0i) + 16 * (kc & 3) + 8 * h; const f32x4 x0 = *(const GAS f32x4*)src, x1 = *(const GAS f32x4*)(src + 4);
                    acc = MFMA32(va[kc], pack8(x0.x, x0.y, x0.z, x0.w, x1.x, x1.y, x1.z, x1.w), acc); }
                s5_y_store(F, acc, g, tok0, 2 * w, h); }
            if (w >= 4) { const int mt = w - 4; f32x16 acc = zero16();
#pragma unroll
                for (int ks = 0; ks < 4; ++ks) acc = MFMA32(ldg8(W4 + ((size_t)g * 128 + 32 * mt + r) * 64 + 16 * ks + 8 * h), ldg8(up + (size_t)ks * S5W), acc);
                const float* A4 = (const float*)(F.ws + WS_APOW) + 2 * (size_t)g * SN;
#pragma unroll
                for (int rq = 0; rq < 4; ++rq) { const int n0 = 32 * (mt & 1) + 8 * rq + 4 * h; const f32x4 hr = *(const GAS f32x4*)(h0r + n0), hi = *(const GAS f32x4*)(h0i + n0); f32x4 o;
#pragma unroll
                    for (int e = 0; e < 4; ++e) { const float a4r = A4[2 * (n0 + e)], a4i = A4[2 * (n0 + e) + 1];
                        o[e] = acc[4 * rq + e] + (mt < 2 ? (a4r * hr[e] - a4i * hi[e]) : (a4r * hi[e] + a4i * hr[e])); }
                    *(GAS f32x4*)(F.out + (mt < 2 ? O_S5RS : O_S5IS) + ((size_t)bs * SG + g) * SN + n0) = o; }
            }
        }
    }
    __syncthreads();
}
constexpr int HG_PAR = 43520;
constexpr int HG_QT = 0, HG_KT = 8704, HG_VT = 17408, HG_DL = 26112, HG_OT = 26624;
constexpr int HG_RAWF = 2 * HG_PAR, HG_RAWQ = HG_RAWF + 2 * 8704, HG_END = HG_RAWQ + 2 * 8704;
static_assert(HG_END <= RING_BYTES, "HGRN2 LDS map");
typedef short v4i16_t __attribute__((ext_vector_type(4)));
DI s16x4 tr16(LAS unsigned char* p) { return __builtin_bit_cast(s16x4, __builtin_amdgcn_ds_read_tr16_b64_v4i16((LAS v4i16_t*)p)); }
DI bf16x8 cat8(s16x4 a, s16x4 b) { return __builtin_shufflevector(a, b, 0, 1, 2, 3, 4, 5, 6, 7); }
DI void hg_prompt(Frame& F, int b, int hd) {
    const int tid = F.tid, lane = F.lane, w = F.wave, c16 = lane & 15, qd = lane >> 4;
    const bf16* Q = (const bf16*)(F.ws + WS_S0); const _Float16* FG = (const _Float16*)(F.ws + WS_S1); const bf16* V = (const bf16*)(F.ws + WS_S2); const bf16* Gt = (const bf16*)(F.ws + WS_S3);
    bf16* YH = (bf16*)(F.ws + WS_YH);
    constexpr int NCH = SEQ / 32;
    const size_t colb = (size_t)hd * DK, tb0 = (size_t)b * SEQ;
    const int pt = tid >> 3, pp = tid & 7;
    const int sch = tid & 127, shalf = (tid >> 7) & 1;
    v4u rf0, rf1, rq0, rq1, rv0, rv1, kv0, kv1, kn0, kn1, rg0, rg1;
    rf0 = rf1 = rq0 = rq1 = rv0 = rv1 = kv0 = kv1 = kn0 = kn1 = rg0 = rg1 = (v4u){0u, 0u, 0u, 0u};
    f32x4 S[2][8];
#pragma unroll
    for (int n = 0; n < 2; ++n)
#pragma unroll
        for (int m = 0; m < 8; ++m) S[n][m] = (f32x4){0.f, 0.f, 0.f, 0.f};
#define HG_BODY         if (w < 4) { \
            if (HG_G(i + 2 >= 0 && i + 2 < NCH)) { LAS unsigned char* rfp = F.lds + HG_RAWF + ((i + 2) & 1) * 8704 + pt * 272 + pp * 32; LAS unsigned char* rqp = F.lds + HG_RAWQ + ((i + 2) & 1) * 8704 + pt * 272 + pp * 32; \
                *(LAS v4u*)rfp = rf0; *(LAS v4u*)(rfp + 16) = rf1; *(LAS v4u*)rqp = rq0; *(LAS v4u*)(rqp + 16) = rq1; kn0 = rv0; kn1 = rv1; } \
            if (HG_G(i >= 1)) { const LAS float* OT = (const LAS float*)(F.lds + ((i - 1) & 1) * HG_PAR + HG_OT) + pt * 132 + 16 * pp; \
                const f32x4 x0 = *(const LAS f32x4*)OT, x1 = *(const LAS f32x4*)(OT + 4), x2 = *(const LAS f32x4*)(OT + 8), x3 = *(const LAS f32x4*)(OT + 12); \
                float ss = (x0.x * x0.x + x0.y * x0.y) + (x0.z * x0.z + x0.w * x0.w) + (x1.x * x1.x + x1.y * x1.y) + (x1.z * x1.z + x1.w * x1.w) \
                         + (x2.x * x2.x + x2.y * x2.y) + (x2.z * x2.z + x2.w * x2.w) + (x3.x * x3.x + x3.y * x3.y) + (x3.z * x3.z + x3.w * x3.w); \
                ss += __shfl_xor(ss, 1); ss += __shfl_xor(ss, 2); ss += __shfl_xor(ss, 4); \
                const float rstd = 1.f / sqrtf(ss * (1.f / DV) + EPS); \
                v4u o0, o1; \
                o0.x = cvt_pk_bf16(x0.x * rstd * bflo(rg0.x), x0.y * rstd * bfhi(rg0.x)); o0.y = cvt_pk_bf16(x0.z * rstd * bflo(rg0.y), x0.w * rstd * bfhi(rg0.y)); \
                o0.z = cvt_pk_bf16(x1.x * rstd * bflo(rg0.z), x1.y * rstd * bfhi(rg0.z)); o0.w = cvt_pk_bf16(x1.z * rstd * bflo(rg0.w), x1.w * rstd * bfhi(rg0.w)); \
                o1.x = cvt_pk_bf16(x2.x * rstd * bflo(rg1.x), x2.y * rstd * bfhi(rg1.x)); o1.y = cvt_pk_bf16(x2.z * rstd * bflo(rg1.y), x2.w * rstd * bfhi(rg1.y)); \
                o1.z = cvt_pk_bf16(x3.x * rstd * bflo(rg1.z), x3.y * rstd * bfhi(rg1.z)); o1.w = cvt_pk_bf16(x3.z * rstd * bflo(rg1.w), x3.w * rstd * bfhi(rg1.w)); \
                bf16* yp = YH + (tb0 + 32 * (i - 1) + pt) * D + colb + 16 * pp; *(GAS v4u*)yp = o0; *(GAS v4u*)(yp + 8) = o1; } \
            if (HG_G(i >= 0 && i < NCH)) { const size_t off = (tb0 + 32 * i + pt) * D + colb + 16 * pp; rg0 = *(const GAS v4u*)(Gt + off); rg1 = *(const GAS v4u*)(Gt + off + 8); } \
            if (HG_G(i + 3 < NCH)) { const size_t off = (tb0 + 32 * (i + 3) + pt) * D + colb + 16 * pp; \
                rf0 = *(const GAS v4u*)(FG + off); rf1 = *(const GAS v4u*)(FG + off + 8); rq0 = *(const GAS v4u*)(Q + off); rq1 = *(const GAS v4u*)(Q + off + 8); rv0 = *(const GAS v4u*)(V + off); rv1 = *(const GAS v4u*)(V + off + 8); } \
            if (HG_G(i + 1 >= 0 && i + 1 < NCH)) { const int par = (i + 1) & 1; LAS unsigned char* base = F.lds + par * HG_PAR; \
                const LAS unsigned char* rfp = F.lds + HG_RAWF + par * 8704 + sch * 2; const LAS unsigned char* rqp = F.lds + HG_RAWQ + par * 8704 + sch * 2; \
                float P = 1.f; \
                if (shalf) { \
 _Pragma("unroll")  \
                    for (int t = 0; t < 16; ++t) P *= (float)*(const LAS _Float16*)(rfp + t * 272); } \
 _Pragma("unroll")  \
                for (int t2 = 0; t2 < 16; ++t2) { const int t = 16 * shalf + t2; const float f = (float)*(const LAS _Float16*)(rfp + t * 272), q = bf2f(*(const LAS bf16*)(rqp + t * 272)); \
                    P *= f; *(LAS bf16*)(base + HG_QT + t * 272 + sch * 2) = (bf16)f2bf(q * P); *(LAS bf16*)(base + HG_KT + t * 272 + sch * 2) = (bf16)f2bf((1.0f - f) * frcp(P)); } \
                if (shalf) *(LAS float*)(base + HG_DL + sch * 4) = P; \
                *(LAS v4u*)(base + HG_VT + pt * 272 + pp * 32) = kv0; *(LAS v4u*)(base + HG_VT + pt * 272 + pp * 32 + 16) = kv1; } \
            kv0 = kn0; kv1 = kn1; \
        } else if (HG_G(i >= 0 && i < NCH)) { \
            const int cw = w - 4; LAS unsigned char* base = F.lds + (i & 1) * HG_PAR; \
            LAS unsigned char* QT = base + HG_QT; LAS unsigned char* KT = base + HG_KT; LAS unsigned char* VT = base + HG_VT; const LAS float* DL = (const LAS float*)(base + HG_DL); LAS float* OT = (LAS float*)(base + HG_OT); \
            f32x4 z4 = {0.f, 0.f, 0.f, 0.f}, p00 = z4, p01 = z4, p11 = z4, o[2][2] = {{z4, z4}, {z4, z4}}; \
 _Pragma("unroll")  \
            for (int ks = 0; ks < 4; ++ks) { const int kb = (32 * ks + 8 * qd) * 2; \
                const bf16x8 ka0 = *(const LAS bf16x8*)(KT + c16 * 272 + kb), ka1 = *(const LAS bf16x8*)(KT + (16 + c16) * 272 + kb); \
                const bf16x8 qb0 = *(const LAS bf16x8*)(QT + c16 * 272 + kb), qb1 = *(const LAS bf16x8*)(QT + (16 + c16) * 272 + kb); \
                p00 = MFMA16(ka0, qb0, p00); p01 = MFMA16(ka0, qb1, p01); p11 = MFMA16(ka1, qb1, p11); } \
 _Pragma("unroll")  \
            for (int e = 0; e < 4; ++e) { if (4 * qd + e > c16) { p00[e] = 0.f; p11[e] = 0.f; } } \
 _Pragma("unroll")  \
            for (int ks = 0; ks < 4; ++ks) { const int kb = (32 * ks + 4 * qd) * 2; \
                const bf16x8 qa0 = cat8(*(const LAS s16x4*)(QT + c16 * 272 + kb), *(const LAS s16x4*)(QT + c16 * 272 + kb + 32)); \
                const bf16x8 qa1 = cat8(*(const LAS s16x4*)(QT + (16 + c16) * 272 + kb), *(const LAS s16x4*)(QT + (16 + c16) * 272 + kb + 32)); \
 _Pragma("unroll")  \
                for (int n = 0; n < 2; ++n) { const bf16x8 sb = pack8(S[n][2 * ks][0], S[n][2 * ks][1], S[n][2 * ks][2], S[n][2 * ks][3], S[n][2 * ks + 1][0], S[n][2 * ks + 1][1], S[n][2 * ks + 1][2], S[n][2 * ks + 1][3]); \
                    o[0][n] = MFMA16(qa0, sb, o[0][n]); o[1][n] = MFMA16(qa1, sb, o[1][n]); } } \
            const int trb = (4 * qd + (c16 >> 2)) * 272 + (c16 & 3) * 8; \
            const bf16x8 pa0 = pack8(p00[0], p00[1], p00[2], p00[3], 0.f, 0.f, 0.f, 0.f), pa1 = pack8(p01[0], p01[1], p01[2], p01[3], p11[0], p11[1], p11[2], p11[3]); \
            bf16x8 vb[2]; \
 _Pragma("unroll")  \
            for (int n = 0; n < 2; ++n) { vb[n] = cat8(tr16(VT + trb + 64 * cw + 32 * n), tr16(VT + trb + 16 * 272 + 64 * cw + 32 * n)); \
                o[0][n] = MFMA16(pa0, vb[n], o[0][n]); o[1][n] = MFMA16(pa1, vb[n], o[1][n]); } \
 _Pragma("unroll")  \
            for (int m = 0; m < 8; ++m) { const bf16x8 kta = cat8(tr16(KT + trb + 32 * m), tr16(KT + trb + 16 * 272 + 32 * m)); const f32x4 dl = *(const LAS f32x4*)(DL + 16 * m + 4 * qd); \
 _Pragma("unroll")  \
                for (int n = 0; n < 2; ++n) { S[n][m] = MFMA16(kta, vb[n], S[n][m]); S[n][m] = S[n][m] * dl; } } \
 _Pragma("unroll")  \
            for (int n = 0; n < 2; ++n) \
 _Pragma("unroll")  \
                for (int e = 0; e < 4; ++e) { OT[(4 * qd + e) * 132 + 32 * cw + 16 * n + c16] = o[0][n][e]; OT[(16 + 4 * qd + e) * 132 + 32 * cw + 16 * n + c16] = o[1][n][e]; } \
        } \
        asm volatile("s_waitcnt lgkmcnt(0)" ::: "memory"); __builtin_amdgcn_s_barrier(); asm volatile("" ::: "memory");
#define HG_G(x) (x)
#pragma unroll 1
    for (int i = -3; i <= 0; ++i) { HG_BODY }
#undef HG_G
#define HG_G(x) (true)
#pragma unroll 1
    for (int i = 1; i <= NCH - 4; ++i) { HG_BODY }
#undef HG_G
#define HG_G(x) (x)
#pragma unroll 1
    for (int i = NCH - 3; i <= NCH; ++i) { HG_BODY }
#undef HG_G
#undef HG_BODY
    if (w >= 4) { float* So = F.out + O_HGP + ((size_t)b * HH + hd) * DK * DV; const int cw = w - 4;
#pragma unroll
        for (int n = 0; n < 2; ++n)
#pragma unroll
            for (int m = 0; m < 8; ++m)
#pragma unroll
                for (int e = 0; e < 4; ++e) So[(size_t)(16 * m + 4 * qd + e) * DV + 32 * cw + 16 * n + c16] = S[n][m][e]; }
    __syncthreads();
}
constexpr int HS_QS = 0, HS_KS = 2048, HS_VS = 4096, HS_DL = 6144, HS_PS = 6656, HS_SS = 6784, HS_RED = 8192;
DI void hg_sample(Frame& F, int bs, int hd) {
    const int tid = F.tid, lane = F.lane, w = F.wave;
    const bf16* Q = (const bf16*)(F.ws + WS_S0); const _Float16* FG = (const _Float16*)(F.ws + WS_S1); const bf16* V = (const bf16*)(F.ws + WS_S2); const bf16* Gt = (const bf16*)(F.ws + WS_S3);
    bf16* YH = (bf16*)(F.ws + WS_YH);
    LAS float* QS = (LAS float*)(F.lds + HS_QS); LAS float* KS = (LAS float*)(F.lds + HS_KS); LAS float* VS = (LAS float*)(F.lds + HS_VS); LAS float* DLs = (LAS float*)(F.lds + HS_DL);
    LAS float* PS = (LAS float*)(F.lds + HS_PS); LAS float* SS = (LAS float*)(F.lds + HS_SS); LAS float* RED = (LAS float*)(F.lds + HS_RED);
    const size_t R0 = (size_t)MP + 4 * bs, colb = (size_t)hd * DK;
    const int dv4 = tid & 31, kg = tid >> 5;
    const float* S0 = F.in[4] + ((size_t)bs * HH + hd) * DK * DV; float* So = F.out + O_HGS + ((size_t)bs * HH + hd) * DK * DV;
    f32x4 s[8];
#pragma unroll
    for (int i = 0; i < 8; ++i) s[i] = *(const GAS f32x4*)(S0 + (size_t)(kg + 16 * i) * DV + 4 * dv4);
    if (tid < 128) { const int ch = tid; float P = 1.f;
#pragma unroll
        for (int t = 0; t < 4; ++t) { const float f = (float)FG[(R0 + t) * D + colb + ch], q = bf2f(Q[(R0 + t) * D + colb + ch]); P *= f;
            QS[t * 128 + ch] = q * P; KS[t * 128 + ch] = (1.0f - f) * frcp(P); }
        DLs[ch] = P;
    } else if (tid < 256) { const int ch = tid - 128;
#pragma unroll
        for (int t = 0; t < 4; ++t) VS[t * 128 + ch] = bf2f(V[(R0 + t) * D + colb + ch]); }
    __syncthreads();
#pragma unroll
    for (int pi = 0; pi < 2; ++pi) { const int p = w + 8 * pi; if (p < 10) { int t = 0, s2 = p; while (s2 > t) { s2 -= t + 1; ++t; }
            const float v = wave_sum(QS[t * 128 + lane] * KS[s2 * 128 + lane] + QS[t * 128 + 64 + lane] * KS[s2 * 128 + 64 + lane]); if (lane == 0) PS[t * 4 + s2] = v; } }
    f32x4 acc[4];
#pragma unroll
    for (int t = 0; t < 4; ++t) acc[t] = (f32x4){0.f, 0.f, 0.f, 0.f};
    f32x4 vs[4];
#pragma unroll
    for (int t = 0; t < 4; ++t) vs[t] = *(const LAS f32x4*)(VS + t * 128 + 4 * dv4);
#pragma unroll
    for (int i = 0; i < 8; ++i) { const int k = kg + 16 * i; f32x4 x = s[i];
#pragma unroll
        for (int t = 0; t < 4; ++t) { acc[t] = acc[t] + x * QS[t * 128 + k]; }
#pragma unroll
        for (int t = 0; t < 4; ++t) x = x + vs[t] * KS[t * 128 + k];
        *(GAS f32x4*)(So + (size_t)k * DV + 4 * dv4) = x * DLs[k]; }
#pragma unroll
    for (int t = 0; t < 4; ++t) *(LAS f32x4*)(RED + (kg * 4 + t) * 128 + 4 * dv4) = acc[t];
    __syncthreads();
    {   const int t = tid >> 7, dv = tid & 127; float o = 0.f;
#pragma unroll
        for (int k2 = 0; k2 < 16; ++k2) o += RED[(k2 * 4 + t) * 128 + dv];
        for (int s2 = 0; s2 <= t; ++s2) o += PS[t * 4 + s2] * VS[s2 * 128 + dv];
        const float ss = wave_sum(o * o); if (lane == 0) SS[w] = ss;
        __syncthreads();
        const float rstd = 1.f / sqrtf((SS[2 * t] + SS[2 * t + 1]) * (1.f / DV) + EPS);
        YH[(R0 + t) * D + colb + dv] = (bf16)f2bf(o * rstd * bf2f(Gt[(R0 + t) * D + colb + dv])); }
    __syncthreads();
}
DI void norm1_row(const Frame& F, int m) {
    const GAS f32x4* rr = (const GAS f32x4*)((const float*)(F.ws + WS_RAW1) + (size_t)m * D) + F.lane; const GAS f32x4* xr = (const GAS f32x4*)xrow(F, m) + F.lane;
    const GAS f32x4* g1 = (const GAS f32x4*)F.in[6] + F.lane; const GAS f32x4* g2 = (const GAS f32x4*)F.in[7] + F.lane;
    f32x4 v[4]; float s = 0.f;
#pragma unroll
    for (int j = 0; j < 4; ++j) { v[j] = rr[64 * j]; s += (v[j].x * v[j].x + v[j].y * v[j].y) + (v[j].z * v[j].z + v[j].w * v[j].w); }
    const float rstd = 1.f / sqrtf(wave_sum(s) * (1.f / D) + EPS); float s2 = 0.f;
    GAS f32x4* o = (GAS f32x4*)(F.out + O_Y + (size_t)m * D) + F.lane;
#pragma unroll
    for (int j = 0; j < 4; ++j) { v[j] = xr[64 * j] + v[j] * rstd * g1[64 * j]; o[64 * j] = v[j]; s2 += (v[j].x * v[j].x + v[j].y * v[j].y) + (v[j].z * v[j].z + v[j].w * v[j].w); }
    const float rstd2 = 1.f / sqrtf(wave_sum(s2) * (1.f / D) + EPS);
    GAS unsigned long long* o8 = (GAS unsigned long long*)((bf16*)(F.ws + WS_S3) + (size_t)m * D) + F.lane;
#pragma unroll
    for (int j = 0; j < 4; ++j) { const f32x4 gg = g2[64 * j];
        o8[64 * j] = (unsigned long long)pk2(v[j].x * rstd2 * gg.x, v[j].y * rstd2 * gg.y) | ((unsigned long long)pk2(v[j].z * rstd2 * gg.z, v[j].w * rstd2 * gg.w) << 32); }
}
DI void norm2_row(const Frame& F, int m) {
    const GAS f32x4* rr = (const GAS f32x4*)((const float*)(F.ws + WS_RAW2) + (size_t)m * D) + F.lane; const GAS f32x4* g1 = (const GAS f32x4*)F.in[8] + F.lane;
    GAS f32x4* o = (GAS f32x4*)(F.out + O_Y + (size_t)m * D) + F.lane;
    f32x4 v[4]; float s = 0.f;
#pragma unroll
    for (int j = 0; j < 4; ++j) { v[j] = rr[64 * j]; s += (v[j].x * v[j].x + v[j].y * v[j].y) + (v[j].z * v[j].z + v[j].w * v[j].w); }
    const float rstd = 1.f / sqrtf(wave_sum(s) * (1.f / D) + EPS);
#pragma unroll
    for (int j = 0; j < 4; ++j) o[64 * j] = o[64 * j] + v[j] * rstd * g1[64 * j];
}

struct Args { const float* in[28]; float* out; unsigned char* ws; int ph_lo, ph_hi, li, pad; };
__global__ void __launch_bounds__(NWAVES * 64, 2) mk_fwd(Args args) {
    extern __shared__ __attribute__((aligned(16))) unsigned char lds[];
    Frame F;
    F.lds = (LAS unsigned char*)lds; F.MISC = (volatile LAS unsigned*)(F.lds + MISC_OFF);
    F.tid = threadIdx.x; F.lane = F.tid & 63; F.wave = __builtin_amdgcn_readfirstlane(F.tid >> 6);
    F.G = gridDim.x; { const int bx = blockIdx.x; F.vcu = (F.G % 8 == 0) ? (bx % 8) * (F.G / 8) + bx / 8 : bx; }
#pragma unroll
    for (int i = 0; i < 28; ++i) F.in[i] = args.in[i];
    F.out = args.out; F.ws = args.ws; F.ctl = (gu32*)(args.ws + WS_CTL);
    for (int u = F.tid; u < (LDS_BYTES - LDSCTL_OFF) / 4; u += NWAVES * 64) ((LAS unsigned*)(F.lds + LDSCTL_OFF))[u] = 0u;
    __syncthreads();
    XcdBarrier bar; bar.bar = (unsigned*)(F.ctl + CW_BAR); bar.x = 0; bar.st = nullptr;
    if (N_LAUNCHES == 1) bar = xcd_barrier_post((unsigned*)(F.ctl + CW_BAR), F.MISC + 8);
#define GRID_BAR() do { if (N_LAUNCHES == 1) xcd_barrier(bar); } while (0)
    const int lo = args.ph_lo, hi = args.ph_hi;
#define IN(k) (lo <= (k) && (k) < hi)
#define BOTH(k) (IN(k) && IN((k) + 1))
#ifndef MK_REPEAT
#define MK_REPEAT -1
#endif
    const int gw = F.vcu * NWAVES + F.wave, NGW = F.G * NWAVES;
    const int bx = (int)blockIdx.x;
    if (IN(0)) { p0_prologue(F); if (BOTH(0)) GRID_BAR(); }
    if (IN(1)) {
        pg8::Gemm g{(const bf16*)(F.ws + WS_XN), (const bf16*)(F.ws + WS_WIN), M, NIN, D}; pg8::StaticOrder S; S.init(M, NIN, F.G, bx);
        pg8::EpiIn E{(bf16*)(F.ws + WS_U), (bf16*)(F.ws + WS_S0), (bf16*)(F.ws + WS_S1), (bf16*)(F.ws + WS_S2), (bf16*)(F.ws + WS_S3), (bf16*)F.out, (bf16*)F.out + (size_t)M * D, F.in[10], F.in[21], F.in[22]};
        pg8::gemm_phase<pg8::EpiIn, pg8::StaticOrder, true, true>(F.lds, g, S, E);
        if (BOTH(1)) GRID_BAR();
    }
    if (IN(2)) {
#ifndef MK_RPT2
#define MK_RPT2 0
#endif
        { const int g = bx >> 3, b = bx & 7; if (bx < SG * NB) { s5_chain(F, g, b, b < 4 ? b : -1); if (MK_RPT2 == 1) s5_chain(F, g, b, b < 4 ? b : -1); } }
        if (bx < NB * HH) { hg_prompt(F, bx >> 3, bx & 7); if (MK_RPT2 == 2) hg_prompt(F, bx >> 3, bx & 7); }
        else { for (int it = bx - NB * HH; it < DB * HH; it += F.G - NB * HH) hg_sample(F, it >> 3, it & 7);
               if (MK_RPT2 == 3) for (int it = bx - NB * HH; it < DB * HH; it += F.G - NB * HH) hg_sample(F, it >> 3, it & 7); }
        if (BOTH(2)) GRID_BAR();
    }
    if (IN(3)) {
        pg8::Gemm g{(const bf16*)(F.ws + WS_YG), (const bf16*)(F.ws + WS_WGLU), M, S5W, S5W}; pg8::StaticOrder S; S.init(M, S5W, F.G, bx);
        pg8::EpiElem<0> E{(bf16*)(F.ws + WS_YS5), (const bf16*)(F.ws + WS_YG), S5W, F.in[20]};
        pg8::gemm_phase<pg8::EpiElem<0>, pg8::StaticOrder, true, true>(F.lds, g, S, E);
        if (BOTH(3)) GRID_BAR();
    }
    if (IN(4)) {
        { pg8::Gemm g{(const bf16*)(F.ws + WS_YS5), (const bf16*)(F.ws + WS_WBRS), M, D, S5W}; pg8::StaticOrder S; S.init(M, D, F.G, bx);
          pg8::EpiElem<1> E{(bf16*)(F.ws + WS_S2), (const bf16*)F.out, D, nullptr};
          pg8::gemm_phase<pg8::EpiElem<1>, pg8::StaticOrder, true, true>(F.lds, g, S, E); }
        VM_WAIT(); __syncthreads(); __builtin_amdgcn_fence(__ATOMIC_ACQUIRE, "agent"); VM_WAIT(); __syncthreads();
        { pg8::Gemm g{(const bf16*)(F.ws + WS_YH), (const bf16*)(F.ws + WS_WBRH), M, D, D}; pg8::StaticOrder S; S.init(M, D, F.G, bx);
          pg8::EpiElem<2> E{(bf16*)(F.ws + WS_S2), (const bf16*)F.out + (size_t)M * D, D, nullptr};
          pg8::gemm_phase<pg8::EpiElem<2>, pg8::StaticOrder, true, true>(F.lds, g, S, E); }
        if (BOTH(4)) GRID_BAR();
    }
    if (IN(5)) {
        pg8::Gemm g{(const bf16*)(F.ws + WS_S2), (const bf16*)(F.ws + WS_WOUT), M, D, D}; pg8::StaticOrder S; S.init(M, D, F.G, bx);
        pg8::EpiRaw E{(float*)(F.ws + WS_RAW1), D};
        pg8::gemm_phase<pg8::EpiRaw, pg8::StaticOrder, true, true>(F.lds, g, S, E);
        if (BOTH(5)) GRID_BAR();
    }
    if (IN(6)) { for (int m = gw; m < M; m += NGW) norm1_row(F, m); if (BOTH(6)) GRID_BAR(); }
    if (IN(7)) {
        pg8::Gemm g{(const bf16*)(F.ws + WS_S3), (const bf16*)(F.ws + WS_WUP), M, FF, D}; pg8::StaticOrder S; S.init(M, FF, F.G, bx);
        pg8::EpiElem<3> E{(bf16*)(F.ws + WS_HMID), nullptr, FF, nullptr};
        pg8::gemm_phase<pg8::EpiElem<3>, pg8::StaticOrder, true, true>(F.lds, g, S, E);
        if (BOTH(7)) GRID_BAR();
    }
    if (IN(8)) {
        pg8::Gemm g{(const bf16*)(F.ws + WS_HMID), (const bf16*)(F.ws + WS_WDN), M, D, FF}; pg8::StaticOrder S; S.init(M, D, F.G, bx);
        pg8::EpiRaw E{(float*)(F.ws + WS_RAW2), D};
        pg8::gemm_phase<pg8::EpiRaw, pg8::StaticOrder, true, true>(F.lds, g, S, E);
        if (BOTH(8)) GRID_BAR();
    }
    if (IN(9)) { for (int m = gw; m < M; m += NGW) norm2_row(F, m); }
#undef IN
#undef BOTH
}

#if defined(MK_DEBUG) && MK_DEBUG
constexpr int CW_DBG = 8;
DI bool dclose(float got, float ex, float tol) { return fabsf(got - ex) <= tol + tol * fabsf(ex); }
DI void dflag(unsigned char* ws, int bit) { atomicOr((unsigned*)(ws + WS_CTL) + CW_DBG, 1u << bit); }
DI float ddot(const bf16* a, const bf16* b, int K) { float s = 0.f; for (int k = 0; k < K; ++k) s += bf2f(a[k]) * bf2f(b[k]); return s; }
__global__ void __launch_bounds__(512) dbg_check(Args args, int which) {
    __shared__ float red[8 * 128 + 64];
    unsigned char* ws = args.ws; const int tid = threadIdx.x, lane = tid & 63, w = tid >> 6, bx = blockIdx.x;
    const unsigned idx = bx * 512 + tid; const unsigned hsh = idx * 2654435761u;
    const bf16* U = (const bf16*)(ws + WS_U); const bf16* Q = (const bf16*)(ws + WS_S0); const _Float16* LF = (const _Float16*)(ws + WS_S1); const bf16* V = (const bf16*)(ws + WS_S2); const bf16* Gt = (const bf16*)(ws + WS_S3);
    const bf16* GS5 = (const bf16*)args.out; const bf16* GHG = (const bf16*)args.out + (size_t)M * D; const bf16* YG = (const bf16*)(ws + WS_YG); const bf16* YS5 = (const bf16*)(ws + WS_YS5); const bf16* YH = (const bf16*)(ws + WS_YH);
    const bf16* MG = (const bf16*)(ws + WS_S2);
    if (which == 1) {
        const int row = hsh % M, col = (hsh >> 7) % NIN;
        float v = ddot((const bf16*)(ws + WS_XN) + (size_t)row * D, (const bf16*)(ws + WS_WIN) + (size_t)col * D, D) + args.in[10][col];
        float got; bool ok;
        if (col < 512) { got = bf2f(U[(size_t)row * 512 + col]); ok = dclose(got, v, 0.02f); }
        else { const int s = (col - 512) >> 10, c = (col - 512) & 1023; const size_t o = (size_t)row * D + c;
            if (s == 0) { got = bf2f(Q[o]); ok = dclose(got, v / (1.f + expf(-v)), 0.02f); }
            else if (s == 1) { const float l0 = args.in[21][c], l1 = args.in[21][1024 + c], lb = expf(l0) / (expf(l0) + expf(l1)); got = (float)LF[o]; ok = dclose(got, logf(lb + (1.f - lb) / (1.f + expf(-v))), 0.01f); }
            else if (s == 2) { got = bf2f(V[o]); ok = dclose(got, v, 0.02f); }
            else if (s == 3) { got = bf2f(Gt[o]); ok = dclose(got, v / (1.f + expf(-v)), 0.02f); }
            else if (s == 4) { got = bf2f(GS5[o]); ok = dclose(got, 1.f / (1.f + expf(-v)), 0.02f); }
            else { got = bf2f(GHG[o]); ok = dclose(got, 1.f / (1.f + expf(-v)), 0.02f); } }
        if (!ok) { int sg = col < 512 ? 0 : 1 + ((col - 512) >> 10); dflag(ws, sg); atomicAdd((unsigned*)(ws + WS_CTL) + 9, 1u); }
    }
    if (which == 2) {
        if (bx < 64) {
            if (w == 0) { const bool smp = bx >= 32; const int g = smp ? bx - 32 : bx, b = bx & 7, bs = 4 * (bx - 32) + 1, n = lane;
                const float are = args.in[11][g * SN + n], aim = args.in[12][g * SN + n], dt = expf(args.in[13][g]);
                const float mag = expf(dt * are), abr = mag * cosf(dt * aim), abi = mag * sinf(dt * aim), den = are * are + aim * aim, nr = abr - 1.f, ni = abi;
                const float cr = (nr * are + ni * aim) / den, ci = (ni * are - nr * aim) / den;
                float hr = smp ? args.in[2][((size_t)bs * SG + g) * SN + n] : 0.f, hi = smp ? args.in[3][((size_t)bs * SG + g) * SN + n] : 0.f;
                const int L = smp ? 4 : SEQ; const size_t tok0 = smp ? (size_t)MP + 4 * bs : (size_t)b * SEQ; int bad = 0;
                for (int t = 0; t < L; ++t) { float bur = 0.f, bui = 0.f;
                    for (int c = 0; c < 16; ++c) { const float u = bf2f(U[(tok0 + t) * 512 + g * 16 + c]); const float br = args.in[14][((size_t)g * SN + n) * 16 + c], bi = args.in[15][((size_t)g * SN + n) * 16 + c];
                        bur += (cr * br - ci * bi) * u; bui += (cr * bi + ci * br) * u; }
                    const float nhr = abr * hr - abi * hi + bur, nhi = abr * hi + abi * hr + bui; hr = nhr; hi = nhi;
                    for (int c = 0; c < 16; ++c) { float y = args.in[16][((size_t)g * 16 + c) * SN + n] * hr - args.in[17][((size_t)g * 16 + c) * SN + n] * hi; y = wave_sum(y);
                        const float u = bf2f(U[(tok0 + t) * 512 + g * 16 + c]); y += args.in[18][g * 16 + c] * u; y = 0.5f * y * (1.f + tanhf(0.7978845608f * (y + 0.044715f * y * y * y)));
                        if (!dclose(bf2f(YG[(tok0 + t) * 512 + g * 16 + c]), y, 0.04f)) bad = 1; } }
                if (bad) dflag(ws, smp ? 4 : 2);
                const float gr = smp ? args.out[O_S5RS + ((size_t)bs * SG + g) * SN + n] : args.out[O_S5RP + ((size_t)b * SG + g) * SN + n];
                const float gi = smp ? args.out[O_S5IS + ((size_t)bs * SG + g) * SN + n] : args.out[O_S5IP + ((size_t)b * SG + g) * SN + n];
                if (!dclose(gr, hr, 0.03f) || !dclose(gi, hi, 0.03f)) dflag(ws, smp ? 4 : 3); }
        } else if (bx < 192) {
            const bool smp = bx >= 128; const int j = bx - 64, b = j >> 3, hd = bx & 7, bs = 2 * (bx - 128) + 1;
            const int k = tid >> 2, q4 = tid & 3; float S[32];
            const float* S0 = args.in[4] + ((size_t)bs * HH + hd) * DK * DV;
            for (int e = 0; e < 32; ++e) S[e] = smp ? S0[(size_t)k * DV + 32 * q4 + e] : 0.f;
            const int L = smp ? 4 : SEQ; const size_t tok0 = smp ? (size_t)MP + 4 * bs : (size_t)b * SEQ; int bad = 0;
            for (int t = 0; t < L; ++t) { const size_t ro = (tok0 + t) * D + hd * 128;
                const float f = expf((float)LF[ro + k]), kk = 1.f - f, qv = bf2f(Q[ro + k]); float part[32];
                for (int e = 0; e < 32; ++e) { S[e] = f * S[e] + kk * bf2f(V[ro + 32 * q4 + e]); part[e] = qv * S[e]; }
                for (int e = 0; e < 32; ++e) { float p = part[e]; p += __shfl_xor(p, 4); p += __shfl_xor(p, 8); p += __shfl_xor(p, 16); p += __shfl_xor(p, 32); part[e] = p; }
                __syncthreads();
                if (lane < 4) for (int e = 0; e < 32; ++e) red[w * 128 + 32 * q4 + e] = part[e];
                __syncthreads();
                float o = 0.f; if (tid < 128) { for (int w2 = 0; w2 < 8; ++w2) o += red[w2 * 128 + tid]; }
                const float ss = wave_sum(o * o); if (tid < 128 && lane == 0) red[1024 + w] = ss;
                __syncthreads();
                if (tid < 128) { const float rstd = 1.f / sqrtf((red[1024] + red[1025]) / 128.f + EPS); const float ex = o * rstd * args.in[22][tid] * bf2f(Gt[ro + tid]);
                    if (!dclose(bf2f(YH[ro + tid]), ex, 0.05f)) bad = 1; } }
            if (bad) dflag(ws, smp ? 6 : 5);
            const float* So = args.out + (smp ? O_HGS + ((size_t)bs * HH + hd) * DK * DV : O_HGP + ((size_t)b * HH + hd) * DK * DV);
            for (int e = 0; e < 32; ++e) if (!dclose(So[(size_t)k * DV + 32 * q4 + e], S[e], 0.03f)) dflag(ws, smp ? 6 : 5);
        }
    }
    if (which == 3) { const int row = hsh % M, col = (hsh >> 9) % S5W; const float z = ddot(YG + (size_t)row * 512, (const bf16*)(ws + WS_WGLU) + (size_t)col * 512, 512) + args.in[20][col];
        if (!dclose(bf2f(YS5[(size_t)row * 512 + col]), bf2f(YG[(size_t)row * 512 + col]) / (1.f + expf(-z)), 0.02f)) dflag(ws, 7); }
    if (which == 4) { const int row = hsh % M, col = (hsh >> 9) % D; const size_t o = (size_t)row * D + col;
        const float a = ddot(YS5 + (size_t)row * 512, (const bf16*)(ws + WS_WBRS) + (size_t)col * 512, 512), c = ddot(YH + (size_t)row * D, (const bf16*)(ws + WS_WBRH) + (size_t)col * D, D);
        if (!dclose(bf2f(MG[o]), bf2f(GS5[o]) * a + bf2f(GHG[o]) * c, 0.03f)) dflag(ws, 8); }
    if (which == 5) { const int row = hsh % M, col = (hsh >> 9) % D;
        if (!dclose(((const float*)(ws + WS_RAW1))[(size_t)row * D + col], ddot(MG + (size_t)row * D, (const bf16*)(ws + WS_WOUT) + (size_t)col * D, D), 0.02f)) dflag(ws, 9); }
    if (which == 7) { const int row = hsh % M, col = (hsh >> 9) % FF; const float z = fmaxf(ddot((const bf16*)(ws + WS_S3) + (size_t)row * D, (const bf16*)(ws + WS_WUP) + (size_t)col * D, D), 0.f);
        if (!dclose(bf2f(((const bf16*)(ws + WS_HMID))[(size_t)row * FF + col]), z * z, 0.02f)) dflag(ws, 10); }
    if (which == 8) { const int row = hsh % M, col = (hsh >> 9) % D;
        if (!dclose(((const float*)(ws + WS_RAW2))[(size_t)row * D + col], ddot((const bf16*)(ws + WS_HMID) + (size_t)row * FF, (const bf16*)(ws + WS_WDN) + (size_t)col * FF, FF), 0.02f)) dflag(ws, 11); }
    if (which == 6 || which == 9) {
        const int row = (hsh >> 6) % M; const float* raw = (const float*)(ws + (which == 6 ? WS_RAW1 : WS_RAW2)) + (size_t)row * D; const float* x1 = args.out + (size_t)row * D;
        if (which == 6) { const float* xr = row < MP ? args.in[0] + (size_t)row * D : args.in[1] + (size_t)(row - MP) * D; float s = 0.f; for (int c = 0; c < D; ++c) s += raw[c] * raw[c];
            const float rstd = 1.f / sqrtf(s / D + EPS); float s2 = 0.f; int bad = 0;
            for (int c = 0; c < D; ++c) { const float e = xr[c] + raw[c] * rstd * args.in[6][c]; if (!dclose(x1[c], e, 0.001f)) bad = 1; s2 += e * e; }
            const float r2 = 1.f / sqrtf(s2 / D + EPS);
            for (int c = 0; c < D; ++c) if (!dclose(bf2f(((const bf16*)(ws + WS_S3))[(size_t)row * D + c]), x1[c] * r2 * args.in[7][c], 0.02f)) bad = 1;
            if (bad && (tid & 63) == 0) dflag(ws, 12); }
    }
}
__global__ void dbg_report(Args args) { const unsigned m = ((unsigned*)(args.ws + WS_CTL))[CW_DBG], cnt = ((unsigned*)(args.ws + WS_CTL))[9]; if (m) { const int b = __ffs(m) - 1; const float X = ldexpf(1.0f, 26 - b); args.out[0] = X; args.out[(size_t)MP * D] = X * (0.2f + 0.75f * (float)cnt / 131072.f); } }
#endif
extern "C" void kernel_launch(void* const* d_in, const int* in_sizes, int n_in, void* d_out, int out_size, void* d_ws, size_t ws_size, hipStream_t stream) {
    static int grid = 0;
    if (grid == 0) {
        if (n_in != 28 || in_sizes[0] != MP * D || in_sizes[1] != MS * D || (size_t)out_size != O_END || ws_size < WS_END) {
            fprintf(stderr, "kernel_launch: shape mismatch: n_in %d in0 %d in1 %d out %d ws %zu (need %zu); nothing launched\n", n_in, n_in > 0 ? in_sizes[0] : -1, n_in > 1 ? in_sizes[1] : -1, out_size, ws_size, (size_t)WS_END); grid = -1; return; }
        int dev = 0, cus = 0, per_cu = 0;
        if (hipGetDevice(&dev) != hipSuccess || hipDeviceGetAttribute(&cus, hipDeviceAttributeMultiprocessorCount, dev) != hipSuccess) { fprintf(stderr, "kernel_launch: device query failed\n"); grid = -1; return; }
        if (hipFuncSetAttribute((const void*)mk_fwd, hipFuncAttributeMaxDynamicSharedMemorySize, LDS_BYTES) != hipSuccess) { fprintf(stderr, "kernel_launch: hipFuncSetAttribute failed\n"); grid = -1; return; }
        if (hipOccupancyMaxActiveBlocksPerMultiprocessor(&per_cu, (const void*)mk_fwd, NWAVES * 64, LDS_BYTES) != hipSuccess || per_cu < 1) { fprintf(stderr, "kernel_launch: occupancy query says %d blocks per CU\n", per_cu); per_cu = per_cu < 1 ? 0 : per_cu; }
        (void)hipGetLastError();
        grid = cus;
        if (per_cu < 1 || grid != 256) { fprintf(stderr, "kernel_launch: need 256 CUs with one resident block each (cus %d, per_cu %d)\n", cus, per_cu); if (per_cu < 1) { grid = -1; return; } }
    }
    if (grid < 0) return;
    (void)hipMemsetAsync((char*)d_ws + WS_CTL, 0, CTL_ZERO_BYTES, stream);
    Args a{};
    for (int i = 0; i < 28; ++i) a.in[i] = (const float*)d_in[i];
    a.out = (float*)d_out; a.ws = (unsigned char*)d_ws;
    for (int li = 0; li < N_LAUNCHES; ++li) {
        a.ph_lo = (N_LAUNCHES == 1) ? 0 : li; a.ph_hi = (N_LAUNCHES == 1) ? N_PHASES : li + 1; a.li = li; a.pad = 0;
        hipLaunchKernelGGL(mk_fwd, dim3(grid), dim3(NWAVES * 64), LDS_BYTES, stream, a);
        if (N_LAUNCHES == N_PHASES && li == MK_REPEAT) hipLaunchKernelGGL(mk_fwd, dim3(grid), dim3(NWAVES * 64), LDS_BYTES, stream, a);
#if defined(MK_DEBUG) && MK_DEBUG
        if (N_LAUNCHES == N_PHASES && li >= 1 && li <= 8 && ((MK_DEBUG >> li) & 1)) hipLaunchKernelGGL(dbg_check, dim3(256), dim3(512), 0, stream, a, li);
#endif
    }
#if defined(MK_DEBUG) && MK_DEBUG
    hipLaunchKernelGGL(dbg_report, dim3(1), dim3(1), 0, stream, a);
#endif
}
```
